# Optimizing an MI355X kernel written in HIP

```python
import math
import jax, jax.numpy as jnp
from jax import lax
import numpy as np

D_MODEL = 1024
BATCH = 8
SEQ = 4096
DEPTH = 1

DIFF_HEADS = 4
DIFF_HEAD_DIM = 64
DIFF_V_DIM = 2 * DIFF_HEAD_DIM
DIFF_QK_COLS = DIFF_HEADS * 2 * DIFF_HEAD_DIM
DIFF_V_COLS = DIFF_HEADS * DIFF_V_DIM
MLA_HEADS = 4
MLA_Q_RANK = 384
MLA_KV_RANK = 256
MLA_NOPE_DIM = 128
MLA_ROPE_DIM = 64
MLA_V_DIM = 128
MLA_V_COLS = MLA_HEADS * MLA_V_DIM
ROPE_BASE = 10000.0
IN_COLS = 2 * DIFF_QK_COLS + DIFF_V_COLS + MLA_Q_RANK + MLA_KV_RANK + MLA_ROPE_DIM
MIX_WIDTH = DIFF_V_COLS + MLA_V_COLS
D_FF = 4 * D_MODEL
REL_BUCKETS = 32
REL_MAX_DIST = 128
Q_BLOCK = 128
NORM_EPS = 1e-6
NEG_INF = -1e30

kernel_name = "hymba_diffattn_mla_sqrelu_block"


def rms_norm(x, gain):
    x32 = x.astype(jnp.float32)
    y = x32 * lax.rsqrt(jnp.mean(x32 * x32, axis=-1, keepdims=True) + NORM_EPS)
    return (y * gain.astype(jnp.float32)).astype(x.dtype)


def t5_bucket(dist):
    n = jnp.maximum(dist, 0)
    max_exact = REL_BUCKETS // 2
    nf = jnp.maximum(n, 1).astype(jnp.float32)
    large = max_exact + (jnp.log(nf / max_exact) / math.log(REL_MAX_DIST / max_exact)
                         * (REL_BUCKETS - max_exact)).astype(jnp.int32)
    large = jnp.minimum(large, REL_BUCKETS - 1)
    return jnp.where(n < max_exact, n, large)


def apply_rope(x, positions):
    inv_freq = ROPE_BASE ** (-jnp.arange(0, MLA_ROPE_DIM, 2, dtype=jnp.float32) / MLA_ROPE_DIM)
    ang = positions.astype(jnp.float32)[:, None] * inv_freq[None, :]
    cos, sin = jnp.cos(ang), jnp.sin(ang)
    x32 = x.astype(jnp.float32)
    x1, x2 = jnp.split(x32, 2, axis=-1)
    out = jnp.concatenate([x1 * cos - x2 * sin, x1 * sin + x2 * cos], axis=-1)
    return out.astype(x.dtype)


def diff_attention(q, k, v, positions, rel_bias, lam, lambda_init, subln):
    B, S = q.shape[0], q.shape[1]
    nb = S // Q_BLOCK
    scale = DIFF_HEAD_DIM ** -0.5
    qb = q.reshape(B, nb, Q_BLOCK, DIFF_HEADS, 2, DIFF_HEAD_DIM).transpose(1, 0, 3, 4, 2, 5)
    kt = k.transpose(0, 2, 3, 1, 4)
    vt = v.transpose(0, 2, 1, 3)
    pos_blocks = positions.reshape(nb, Q_BLOCK)

    def block(args):
        q_blk, q_pos = args
        logits = jnp.einsum('bhcqd,bhckd->bhcqk', q_blk, kt,
                            preferred_element_type=jnp.float32) * scale
        dist = q_pos[:, None] - positions[None, :]
        bias = jnp.transpose(rel_bias[t5_bucket(dist)], (2, 0, 1))
        logits = logits + bias.astype(jnp.float32)[None, :, None]
        logits = jnp.where((dist >= 0)[None, None, None], logits, NEG_INF)
        probs = jax.nn.softmax(logits, axis=-1)
        attn = probs[:, :, 0] - lam * probs[:, :, 1]
        return jnp.einsum('bhqk,bhkd->bhqd', attn.astype(vt.dtype), vt)

    out = lax.map(block, (qb, pos_blocks))
    out = out.transpose(1, 0, 3, 2, 4).reshape(B, S, DIFF_HEADS, DIFF_V_DIM)
    out = rms_norm(out, subln) * (1.0 - lambda_init)
    return out.reshape(B, S, DIFF_V_COLS)


def mla_attention(c_q, c_kv, k_pe, positions, q_norm, w_uq, kv_norm, w_ukv):
    B, S = c_q.shape[0], c_q.shape[1]
    nb = S // Q_BLOCK
    q = (rms_norm(c_q, q_norm) @ w_uq).reshape(B, S, MLA_HEADS, MLA_NOPE_DIM + MLA_ROPE_DIM)
    q = q.transpose(0, 2, 1, 3)
    q_nope, q_pe = q[..., :MLA_NOPE_DIM], q[..., MLA_NOPE_DIM:]
    q_pe = apply_rope(q_pe, positions)
    kv = (rms_norm(c_kv, kv_norm) @ w_ukv).reshape(B, S, MLA_HEADS, MLA_NOPE_DIM + MLA_V_DIM)
    kv = kv.transpose(0, 2, 1, 3)
    k_nope, v = kv[..., :MLA_NOPE_DIM], kv[..., MLA_NOPE_DIM:]
    k_pe = apply_rope(k_pe, positions)
    scale = (MLA_NOPE_DIM + MLA_ROPE_DIM) ** -0.5
    qn_b = q_nope.reshape(B, MLA_HEADS, nb, Q_BLOCK, MLA_NOPE_DIM).transpose(2, 0, 1, 3, 4)
    qp_b = q_pe.reshape(B, MLA_HEADS, nb, Q_BLOCK, MLA_ROPE_DIM).transpose(2, 0, 1, 3, 4)
    pos_blocks = positions.reshape(nb, Q_BLOCK)

    def block(args):
        qn, qp, q_pos = args
        logits = (jnp.einsum('bhqd,bhkd->bhqk', qn, k_nope, preferred_element_type=jnp.float32)
                  + jnp.einsum('bhqr,bkr->bhqk', qp, k_pe, preferred_element_type=jnp.float32)) * scale
        mask = positions[None, :] <= q_pos[:, None]
        logits = jnp.where(mask[None, None], logits, NEG_INF)
        probs = jax.nn.softmax(logits, axis=-1)
        return jnp.einsum('bhqk,bhkd->bhqd', probs.astype(v.dtype), v)

    out = lax.map(block, (qn_b, qp_b, pos_blocks))
    return out.transpose(1, 0, 3, 2, 4).reshape(B, S, MLA_V_COLS)


def setup_inputs(seed: int = 0) -> dict:
    key = jax.random.key(seed)
    ks = jax.random.split(key, 24)
    f32 = jnp.float32

    def nrm(k, shape, scale):
        return jax.random.normal(k, shape, f32) * scale

    def gain(k, shape):
        return 1.0 + 0.02 * jax.random.normal(k, shape, f32)

    return {
        "x": jax.random.normal(ks[0], (BATCH, SEQ, D_MODEL), f32),
        "positions": jnp.arange(SEQ, dtype=jnp.int32),
        "rel_bias": nrm(ks[1], (REL_BUCKETS, DIFF_HEADS), 0.1),
        "norm_attn": gain(ks[2], (DEPTH, D_MODEL)),
        "w_in": nrm(ks[3], (DEPTH, D_MODEL, IN_COLS), D_MODEL ** -0.5),
        "diff_lq1": nrm(ks[4], (DEPTH, DIFF_HEAD_DIM), 0.1),
        "diff_lk1": nrm(ks[5], (DEPTH, DIFF_HEAD_DIM), 0.1),
        "diff_lq2": nrm(ks[6], (DEPTH, DIFF_HEAD_DIM), 0.1),
        "diff_lk2": nrm(ks[7], (DEPTH, DIFF_HEAD_DIM), 0.1),
        "diff_subln": gain(ks[8], (DEPTH, DIFF_V_DIM)),
        "mla_q_norm": gain(ks[9], (DEPTH, MLA_Q_RANK)),
        "mla_w_uq": nrm(ks[10], (DEPTH, MLA_Q_RANK, MLA_HEADS * (MLA_NOPE_DIM + MLA_ROPE_DIM)), MLA_Q_RANK ** -0.5),
        "mla_kv_norm": gain(ks[11], (DEPTH, MLA_KV_RANK)),
        "mla_w_ukv": nrm(ks[12], (DEPTH, MLA_KV_RANK, MLA_HEADS * (MLA_NOPE_DIM + MLA_V_DIM)), MLA_KV_RANK ** -0.5),
        "w_out": nrm(ks[13], (DEPTH, MIX_WIDTH, D_MODEL), MIX_WIDTH ** -0.5),
        "norm_mlp": gain(ks[14], (DEPTH, D_MODEL)),
        "w_mlp_in": nrm(ks[15], (DEPTH, D_MODEL, D_FF), D_MODEL ** -0.5),
        "w_mlp_out": nrm(ks[16], (DEPTH, D_FF, D_MODEL), D_FF ** -0.5),
        "norm_final": gain(ks[17], (D_MODEL,)),
    }


def reference(x, positions, rel_bias, norm_attn, w_in, diff_lq1, diff_lk1, diff_lq2, diff_lk2,
              diff_subln, mla_q_norm, mla_w_uq, mla_kv_norm, mla_w_ukv, w_out, norm_mlp,
              w_mlp_in, w_mlp_out, norm_final):
    B, S = x.shape[0], x.shape[1]
    splits = [DIFF_QK_COLS, 2 * DIFF_QK_COLS, 2 * DIFF_QK_COLS + DIFF_V_COLS,
              2 * DIFF_QK_COLS + DIFF_V_COLS + MLA_Q_RANK,
              2 * DIFF_QK_COLS + DIFF_V_COLS + MLA_Q_RANK + MLA_KV_RANK]
    for l in range(DEPTH):
        lambda_init = 0.8 - 0.6 * math.exp(-0.3 * l)
        h = rms_norm(x, norm_attn[l])
        proj = h @ w_in[l]
        dq, dk, dv, c_q, c_kv, k_pe = jnp.split(proj, splits, axis=-1)
        dq = dq.reshape(B, S, DIFF_HEADS, 2, DIFF_HEAD_DIM)
        dk = dk.reshape(B, S, DIFF_HEADS, 2, DIFF_HEAD_DIM)
        dv = dv.reshape(B, S, DIFF_HEADS, DIFF_V_DIM)
        lam = (jnp.exp(jnp.sum(diff_lq1[l].astype(jnp.float32) * diff_lk1[l].astype(jnp.float32)))
               - jnp.exp(jnp.sum(diff_lq2[l].astype(jnp.float32) * diff_lk2[l].astype(jnp.float32)))
               + lambda_init)
        out_a = diff_attention(dq, dk, dv, positions, rel_bias, lam, lambda_init, diff_subln[l])
        out_b = mla_attention(c_q, c_kv, k_pe, positions, mla_q_norm[l], mla_w_uq[l],
                              mla_kv_norm[l], mla_w_ukv[l])
        x = x + jnp.concatenate([out_a, out_b], axis=-1) @ w_out[l]
        h = rms_norm(x, norm_mlp[l])
        x = x + jnp.square(jax.nn.relu(h @ w_mlp_in[l])) @ w_mlp_out[l]
    return rms_norm(x, norm_final)
```

```cpp
#include <hip/hip_runtime.h>
#include <cstdint>
#include <cstdio>

constexpr int BATCH = 8, SEQ = 4096, DM = 1024, M = BATCH * SEQ;
constexpr int NIN = 2240, NINP = 2304;
constexpr int FF = 4096;
constexpr float EPS = 1e-6f;
constexpr float LOG2E = 1.4426950408889634f;
constexpr float QSCALE_D = 0.125f * LOG2E;
constexpr float QSCALE_M = 0.07216878364870322f * LOG2E;
constexpr float LAMBDA_INIT = 0.2f;

typedef unsigned short bf16_t;
typedef float f32x4 __attribute__((ext_vector_type(4)));
typedef float f32x2 __attribute__((ext_vector_type(2)));
typedef unsigned u32x4 __attribute__((ext_vector_type(4)));
typedef unsigned u32x2 __attribute__((ext_vector_type(2)));

constexpr size_t MiB = 1u << 20;
constexpr size_t WS_SSQ = 0, WS_SSKV = 128 * 1024, WS_SS1 = 256 * 1024, WS_SS2 = 384 * 1024;
constexpr size_t WS_CS = 1 * MiB;
constexpr size_t WS_WIN = 2 * MiB;
constexpr size_t WS_WUQ = 7 * MiB;
constexpr size_t WS_WUKV = 8 * MiB;
constexpr size_t WS_WOUT = 9 * MiB;
constexpr size_t WS_W1 = 11 * MiB;
constexpr size_t WS_W2 = 19 * MiB;
constexpr size_t WS_XN = 32 * MiB;
constexpr size_t WS_MIX = WS_XN;
constexpr size_t WS_QD = 96 * MiB, WS_KD = 128 * MiB, WS_VD = 160 * MiB;
constexpr size_t WS_CQ = 192 * MiB;
constexpr size_t WS_CKV = 216 * MiB;
constexpr size_t WS_KPE = 232 * MiB;
constexpr size_t WS_QN = 236 * MiB;
constexpr size_t WS_QP = 268 * MiB;
constexpr size_t WS_KN = 284 * MiB;
constexpr size_t WS_VM = 316 * MiB;
constexpr size_t WS_X1B = 348 * MiB;
constexpr size_t WS_H = 32 * MiB;
constexpr size_t WS_END = 412 * MiB;

__device__ __forceinline__ float bf2f(bf16_t b) { return __uint_as_float((unsigned)b << 16); }
__device__ __forceinline__ unsigned cvt_pk_bf16(float lo, float hi) { unsigned r; asm("v_cvt_pk_bf16_f32 %0, %1, %2" : "=v"(r) : "v"(lo), "v"(hi)); return r; }
__device__ __forceinline__ float wave_sum(float v) {
#pragma unroll
    for (int o = 1; o < 64; o <<= 1) v += __shfl_xor(v, o);
    return v;
}
__device__ __forceinline__ float wave_max(float v) {
#pragma unroll
    for (int o = 1; o < 64; o <<= 1) v = fmaxf(v, __shfl_xor(v, o));
    return v;
}
__device__ __forceinline__ void store8_bf16(bf16_t* p, const float (&v)[8], float s) {
    u32x4 w; w.x = cvt_pk_bf16(v[0] * s, v[1] * s); w.y = cvt_pk_bf16(v[2] * s, v[3] * s); w.z = cvt_pk_bf16(v[4] * s, v[5] * s); w.w = cvt_pk_bf16(v[6] * s, v[7] * s);
    *(u32x4*)p = w;
}
__device__ __forceinline__ int t5_bucket(int dist) {
    const int n = dist > 0 ? dist : 0;
    if (n < 16) return n;
    const float nf = (float)n;
    const int large = 16 + (int)(logf(nf / 16.f) / 2.0794415416798357f * 16.f);
    return large < 31 ? large : 31;
}
__device__ __forceinline__ void sincos_acc(float ang, float& s, float& c) {
    const double a = (double)ang; const double k = rint(a * 0.63661977236758134308);
    double r = fma(-k, 1.57079632679489655800, a); r = fma(-k, 6.12323399573676603587e-17, r);
    const float x = (float)r, x2 = x * x;
    const float sp = x + x * x2 * (-1.6666654611e-1f + x2 * (8.3321608736e-3f + x2 * (-1.9515295891e-4f)));
    const float cp = 1.0f - 0.5f * x2 + x2 * x2 * (4.166664568298827e-2f + x2 * (-1.388731625493765e-3f + x2 * 2.443315711809948e-5f));
    const int q = ((int)k) & 3;
    const float s0 = (q & 1) ? cp : sp, c0 = (q & 1) ? sp : cp;
    s = (q & 2) ? -s0 : s0; c = ((q == 1) || (q == 2)) ? -c0 : c0;
}

__host__ __device__ __forceinline__ int rope_orig(int p) { return 32 * ((p >> 2) & 1) + 16 * (p >> 5) + 4 * ((p >> 3) & 3) + (p & 3); }
__device__ __forceinline__ void rope8_store(bf16_t* dst  , int p8, const f32x2* cs_row, const float (&v)[8], float sc) {
    const int i0 = (p8 >> 5) * 16 + ((p8 >> 3) & 3) * 4;
    float o1[4], o2[4];
#pragma unroll
    for (int e = 0; e < 4; ++e) { const f32x2 t = cs_row[i0 + e]; const float x1 = v[e] * sc, x2 = v[4 + e] * sc; o1[e] = x1 * t.x - x2 * t.y; o2[e] = x1 * t.y + x2 * t.x; }
    u32x2 a, b; a.x = cvt_pk_bf16(o1[0], o1[1]); a.y = cvt_pk_bf16(o1[2], o1[3]); b.x = cvt_pk_bf16(o2[0], o2[1]); b.y = cvt_pk_bf16(o2[2], o2[3]);
    *(u32x2*)(dst + i0) = a; *(u32x2*)(dst + 32 + i0) = b;
}
struct EpiG1 {
    bf16_t *Qd, *Kd, *Vd, *CQ, *CKV, *KPE; float *ssq, *sskv; const f32x2* cs;
    __device__ __forceinline__ float* ss_ptr(int c8) const { return (c8 >= 1536 && c8 < 1920) ? ssq : (c8 >= 1920 && c8 < 2176) ? sskv : nullptr; }
    __device__ __forceinline__ float apply(int row, int c8, const float (&v)[8]) const {
        if (c8 < 512) { store8_bf16(Qd + (size_t)row * 512 + c8, v, QSCALE_D); return 0.f; }
        if (c8 < 1024) { store8_bf16(Kd + (size_t)row * 512 + (c8 - 512), v, 1.f); return 0.f; }
        if (c8 < 1536) { store8_bf16(Vd + (size_t)row * 512 + (c8 - 1024), v, 1.f); return 0.f; }
        if (c8 < 2176) {
            float s = 0.f;
#pragma unroll
            for (int j = 0; j < 8; ++j) s += v[j] * v[j];
            if (c8 < 1920) store8_bf16(CQ + (size_t)row * 384 + (c8 - 1536), v, 1.f); else store8_bf16(CKV + (size_t)row * 256 + (c8 - 1920), v, 1.f);
            return s;
        }
        if (c8 < 2240) rope8_store(KPE + (size_t)row * 64, c8 - 2176, cs + (size_t)(row & (SEQ - 1)) * 32, v, 1.f);
        return 0.f;
    }
};
struct EpiQ {
    bf16_t *Qn, *Qp; const float* ssq; const f32x2* cs;
    __device__ __forceinline__ float* ss_ptr(int) const { return nullptr; }
    __device__ __forceinline__ float apply(int row, int c8, const float (&v)[8]) const {
        const float rs = rsqrtf(ssq[row] * (1.f / 384.f) + EPS) * QSCALE_M;
        if (c8 < 512) { store8_bf16(Qn + (size_t)row * 512 + c8, v, rs); return 0.f; }
        const int p = c8 - 512;
        rope8_store(Qp + (size_t)row * 256 + (p >> 6) * 64, p & 63, cs + (size_t)(row & (SEQ - 1)) * 32, v, rs);
        return 0.f;
    }
};
struct EpiKV {
    bf16_t *Kn, *Vm; const float* sskv;
    __device__ __forceinline__ float* ss_ptr(int) const { return nullptr; }
    __device__ __forceinline__ float apply(int row, int c8, const float (&v)[8]) const {
        const float rs = rsqrtf(sskv[row] * (1.f / 256.f) + EPS);
        if (c8 < 512) store8_bf16(Kn + (size_t)row * 512 + c8, v, rs); else store8_bf16(Vm + (size_t)row * 512 + (c8 - 512), v, rs);
        return 0.f;
    }
};
struct EpiOut {
    const float* x; float* X1; bf16_t* X1b; float* ss1;
    __device__ __forceinline__ float* ss_ptr(int) const { return ss1; }
    __device__ __forceinline__ float apply(int row, int c8, const float (&v)[8]) const {
        const size_t off = (size_t)row * DM + c8;
        const f32x4 a = *(const f32x4*)(x + off), b = *(const f32x4*)(x + off + 4);
        float o[8] = {a.x + v[0], a.y + v[1], a.z + v[2], a.w + v[3], b.x + v[4], b.y + v[5], b.z + v[6], b.w + v[7]};
        *(f32x4*)(X1 + off) = (f32x4){o[0], o[1], o[2], o[3]}; *(f32x4*)(X1 + off + 4) = (f32x4){o[4], o[5], o[6], o[7]};
        store8_bf16(X1b + off, o, 1.f);
        float s = 0.f;
#pragma unroll
        for (int j = 0; j < 8; ++j) s += o[j] * o[j];
        return s;
    }
};
struct EpiUp {
    bf16_t* H; const float* ss1;
    __device__ __forceinline__ float* ss_ptr(int) const { return nullptr; }
    __device__ __forceinline__ float apply(int row, int c8, const float (&v)[8]) const {
        const float rs = rsqrtf(ss1[row] * (1.f / 1024.f) + EPS);
        float o[8];
#pragma unroll
        for (int j = 0; j < 8; ++j) { const float t = fmaxf(v[j] * rs, 0.f); o[j] = t * t; }
        store8_bf16(H + (size_t)row * FF + c8, o, 1.f);
        return 0.f;
    }
};
struct EpiDown {
    float* X; float* ss2;
    __device__ __forceinline__ float* ss_ptr(int) const { return ss2; }
    __device__ __forceinline__ float apply(int row, int c8, const float (&v)[8]) const {
        const size_t off = (size_t)row * DM + c8;
        const f32x4 a = *(const f32x4*)(X + off), b = *(const f32x4*)(X + off + 4);
        float o[8] = {a.x + v[0], a.y + v[1], a.z + v[2], a.w + v[3], b.x + v[4], b.y + v[5], b.z + v[6], b.w + v[7]};
        *(f32x4*)(X + off) = (f32x4){o[0], o[1], o[2], o[3]}; *(f32x4*)(X + off + 4) = (f32x4){o[4], o[5], o[6], o[7]};
        float s = 0.f;
#pragma unroll
        for (int j = 0; j < 8; ++j) s += o[j] * o[j];
        return s;
    }
};


namespace pg8 {
#define PG8_LAS __attribute__((address_space(3)))
typedef unsigned short bf16_t;
typedef short bf16x8 __attribute__((ext_vector_type(8)));
typedef float f32x4 __attribute__((ext_vector_type(4)));
typedef unsigned u32x4 __attribute__((ext_vector_type(4)));
constexpr int BM = 256, BK = 64, HALF = 128, HTB = HALF * BK * 2  , STAGE_BYTES = 8 * HTB, NXCD = 8, WGM = 8;

__host__ __device__ __forceinline__ int lds_byte(int r, int c) { const int st = (r >> 4) * 2 + (c >> 5), rr = r & 15, cc = c & 31, ob = rr * 64 + cc * 2; return st * 1024 + (ob ^ (((ob >> 9) & 1) << 5)); }
__host__ __device__ __forceinline__ void stage_rc(int b, int& R, int& C) { const int st = b / 1024, sb = b % 1024, swz = sb ^ (((sb >> 9) & 1) << 5); R = (st >> 1) * 16 + swz / 64; C = (st & 1) * 32 + (swz % 64) / 2; }
__host__ __device__ __forceinline__ int perm32(int rho) { const int n = rho >> 4, i = rho & 15; return 8 * (i >> 2) + 4 * n + (i & 3); }

struct Unit { int pm, pn; };
struct Gemm { const bf16_t* A; const bf16_t* Bt; int M, N, K; };

struct StaticOrder {
    int nM, nN, nwg, G, c;
    __host__ __device__ void init(int M, int N, int G_, int c_) { nM = M / BM; nN = N / BM; nwg = nM * nN; G = G_; c = c_; }
    __host__ __device__ bool next(int i, Unit& u) const {
        const long L = (long)i * G + c; if (L >= nwg) return false;
        int wgid = (int)L; { const int q = nwg / NXCD, r = nwg % NXCD, xcd = wgid % NXCD, off = wgid / NXCD; wgid = (xcd < r ? xcd * (q + 1) : r * (q + 1) + (xcd - r) * q) + off; }
        const int nig = WGM * nN, gid = wgid / nig, fm = gid * WGM, gsz = (nM - fm) < WGM ? (nM - fm) : WGM;
        u.pm = fm + ((wgid % nig) % gsz); u.pn = (wgid % nig) / gsz; return true;
    }
    __device__ __forceinline__ void a_ready(const Unit&) const {}
    __device__ __forceinline__ void done(const Unit&) const {}
};

template <class Epi, class Sched, bool ALIGN_EPI = false, bool SP2 = false>
__device__ __forceinline__ void gemm_phase(PG8_LAS unsigned char* lds, const Gemm g, const Sched& S, const Epi& E) {
    const int tid = threadIdx.x, wid = __builtin_amdgcn_readfirstlane(tid >> 6), lane = tid & 63, wr = wid >> 2, wc = wid & 3, fr = lane & 15, fq = lane >> 4;
    const int K = g.K, nt = K / BK;
    unsigned voffA[2], voffB[2];
#pragma unroll
    for (int i = 0; i < 2; ++i) { int R, C; stage_rc(tid * 16 + i * 8192, R, C); const int Rb = Epi::PERM ? ((R & ~31) + perm32(R & 31)) : R;
        voffA[i] = (unsigned)(R * K + C) * 2u; voffB[i] = (unsigned)(Rb * K + C) * 2u; }
    const size_t kstep = (size_t)(BK * 2);
    const size_t hstep = (size_t)HALF * K * 2;
    const size_t tstep = 2 * hstep;
    const unsigned ldsw = (unsigned)wid * 1024u;
    const int aoff = lds_byte(wr * 64 + fr, fq * 8), boff = lds_byte(wc * 32 + fr, fq * 8);
#define PG8_SA(b, h) (((b) * 2 + (h)) * HTB)
#define PG8_SB(b, h) ((4 + (b) * 2 + (h)) * HTB)
#define PG8_STAGE(bufoff, gbase, voff) do { _Pragma("unroll") for (int _i = 0; _i < 2; ++_i) \
        __builtin_amdgcn_global_load_lds((const unsigned*)((const char*)(gbase) + (voff)[_i]), (PG8_LAS unsigned*)(lds + (bufoff) + ldsw + _i * 8192), 16, 0, 0); } while (0)
#define PG8_LDA(dst, b, h) do { _Pragma("unroll") for (int m = 0; m < 4; ++m) _Pragma("unroll") for (int k = 0; k < 2; ++k) dst[m][k] = *(const PG8_LAS bf16x8*)(lds + PG8_SA(b, h) + aoff + m * 2048 + k * 1024); } while (0)
#define PG8_LDB(dst, b, h) do { _Pragma("unroll") for (int n = 0; n < 2; ++n) _Pragma("unroll") for (int k = 0; k < 2; ++k) dst[n][k] = *(const PG8_LAS bf16x8*)(lds + PG8_SB(b, h) + boff + n * 2048 + k * 1024); } while (0)
#define PG8_MMA(ai, bj, At, Bt) do { __builtin_amdgcn_s_setprio(1); _Pragma("unroll") for (int m = 0; m < 4; ++m) _Pragma("unroll") for (int n = 0; n < 2; ++n) _Pragma("unroll") for (int k = 0; k < 2; ++k) \
        acc[ai][bj][m][n] = __builtin_amdgcn_mfma_f32_16x16x32_bf16(Bt[n][k], At[m][k], acc[ai][bj][m][n], 0, 0, 0); __builtin_amdgcn_s_setprio(0); } while (0)
#define PG8_WAIT_V(n) asm volatile("s_waitcnt vmcnt(" #n ")" ::: "memory")
#define PG8_WAIT_L(n) asm volatile("s_waitcnt lgkmcnt(" #n ")" ::: "memory")
#define PG8_BAR __builtin_amdgcn_s_barrier()
#define PG8_SCHED __builtin_amdgcn_sched_barrier(0)
    Unit cur, nxt; int ui = 0;
    if (!S.next(0, cur)) return;
    f32x4 acc[2][2][4][2];
#pragma unroll
    for (int a = 0; a < 2; ++a)
#pragma unroll
        for (int b = 0; b < 2; ++b)
#pragma unroll
            for (int m = 0; m < 4; ++m)
#pragma unroll
                for (int n = 0; n < 2; ++n) acc[a][b][m][n] = (f32x4){0.f, 0.f, 0.f, 0.f};
    bf16x8 At[4][2], B0[2][2], B1[2][2];
    const char* cA = (const char*)g.A + (size_t)cur.pm * tstep; const char* cB = (const char*)g.Bt + (size_t)cur.pn * tstep;
    S.a_ready(cur);
    if constexpr (SP2) {
        PG8_STAGE(PG8_SB(0, 0), cB, voffB); PG8_STAGE(PG8_SB(0, 1), cB + hstep, voffB); PG8_STAGE(PG8_SA(0, 0), cA, voffA); PG8_STAGE(PG8_SA(0, 1), cA + hstep, voffA);
        if (wr == 1) PG8_BAR;
        PG8_WAIT_V(2); PG8_BAR;
        PG8_STAGE(PG8_SB(1, 0), cB + kstep, voffB); PG8_STAGE(PG8_SA(1, 0), cA + kstep, voffA); PG8_STAGE(PG8_SB(1, 1), cB + hstep + kstep, voffB);
        PG8_WAIT_V(6); PG8_BAR;
    } else {
        PG8_STAGE(PG8_SB(0, 0), cB, voffB); PG8_STAGE(PG8_SA(0, 0), cA, voffA); PG8_STAGE(PG8_SB(0, 1), cB + hstep, voffB); PG8_STAGE(PG8_SA(0, 1), cA + hstep, voffA);
        if (wr == 1) PG8_BAR;
        PG8_WAIT_V(4); PG8_BAR;
        PG8_STAGE(PG8_SB(1, 0), cB + kstep, voffB); PG8_STAGE(PG8_SA(1, 0), cA + kstep, voffA); PG8_STAGE(PG8_SB(1, 1), cB + hstep + kstep, voffB);
        PG8_WAIT_V(6); PG8_BAR;
    }
    for (;;) {
        const bool has_next = S.next(ui + 1, nxt);
        const char* nA = has_next ? (const char*)g.A + (size_t)nxt.pm * tstep : cA; const char* nB = has_next ? (const char*)g.Bt + (size_t)nxt.pn * tstep : cB;
        for (int t = 0; t < nt; t += 2) {
            const bool last = (t == nt - 2);
            const char* a1 = cA + (size_t)(t + 1) * kstep;
            const char* a2 = last ? nA : cA + (size_t)(t + 2) * kstep; const char* b2 = last ? nB : cB + (size_t)(t + 2) * kstep;
            const char* a3 = a2 + kstep; const char* b3 = b2 + kstep;
            if (last && has_next) S.a_ready(nxt);
            if constexpr (SP2) {
            PG8_LDB(B0, 0, 0); PG8_LDB(B1, 0, 1); PG8_SCHED; PG8_LDA(At, 0, 0); PG8_STAGE(PG8_SA(1, 1), a1 + hstep, voffA);
            PG8_WAIT_V(8); PG8_WAIT_L(0); PG8_BAR; PG8_MMA(0, 0, At, B0); PG8_MMA(0, 1, At, B1); PG8_BAR; PG8_SCHED;
            PG8_LDA(At, 0, 1); PG8_STAGE(PG8_SB(0, 0), b2, voffB); PG8_STAGE(PG8_SB(0, 1), b2 + hstep, voffB); PG8_STAGE(PG8_SA(0, 0), a2, voffA);
            PG8_WAIT_V(8); PG8_WAIT_L(0); PG8_BAR; PG8_MMA(1, 0, At, B0); PG8_MMA(1, 1, At, B1); PG8_BAR; PG8_SCHED;
            PG8_LDB(B0, 1, 0); PG8_LDB(B1, 1, 1); PG8_SCHED; PG8_LDA(At, 1, 0); PG8_STAGE(PG8_SA(0, 1), a2 + hstep, voffA);
            PG8_WAIT_V(8); PG8_WAIT_L(0); PG8_BAR; PG8_MMA(0, 0, At, B0); PG8_MMA(0, 1, At, B1); PG8_BAR; PG8_SCHED;
            PG8_LDA(At, 1, 1); PG8_STAGE(PG8_SB(1, 0), b3, voffB); PG8_STAGE(PG8_SB(1, 1), b3 + hstep, voffB); PG8_STAGE(PG8_SA(1, 0), a3, voffA);
            PG8_WAIT_V(8); PG8_WAIT_L(0); PG8_BAR; PG8_MMA(1, 0, At, B0); PG8_MMA(1, 1, At, B1); PG8_BAR; PG8_SCHED;
            } else {
            PG8_LDB(B0, 0, 0); PG8_SCHED; PG8_LDA(At, 0, 0); PG8_STAGE(PG8_SA(1, 1), a1 + hstep, voffA);
            PG8_WAIT_L(8); PG8_BAR; PG8_WAIT_L(0); PG8_MMA(0, 0, At, B0); PG8_BAR; PG8_SCHED;
            PG8_LDB(B1, 0, 1); PG8_STAGE(PG8_SB(0, 0), b2, voffB);
            PG8_BAR; PG8_WAIT_L(0); PG8_MMA(0, 1, At, B1); PG8_BAR;
            PG8_LDA(At, 0, 1); PG8_STAGE(PG8_SA(0, 0), a2, voffA);
            PG8_BAR; PG8_WAIT_L(0); PG8_MMA(1, 0, At, B0); PG8_BAR; PG8_SCHED;
            PG8_STAGE(PG8_SB(0, 1), b2 + hstep, voffB);
            PG8_WAIT_V(6); PG8_BAR; PG8_MMA(1, 1, At, B1); PG8_BAR;
            PG8_LDB(B0, 1, 0); PG8_SCHED; PG8_LDA(At, 1, 0); PG8_STAGE(PG8_SA(0, 1), a2 + hstep, voffA);
            PG8_WAIT_L(8); PG8_BAR; PG8_WAIT_L(0); PG8_MMA(0, 0, At, B0); PG8_BAR; PG8_SCHED;
            PG8_LDB(B1, 1, 1); PG8_STAGE(PG8_SB(1, 0), b3, voffB);
            PG8_BAR; PG8_WAIT_L(0); PG8_MMA(0, 1, At, B1); PG8_BAR;
            PG8_LDA(At, 1, 1); PG8_STAGE(PG8_SA(1, 0), a3, voffA);
            PG8_BAR; PG8_WAIT_L(0); PG8_MMA(1, 0, At, B0); PG8_BAR; PG8_SCHED;
            PG8_STAGE(PG8_SB(1, 1), b3 + hstep, voffB);
            PG8_WAIT_V(6); PG8_BAR; PG8_MMA(1, 1, At, B1); PG8_BAR;
            }
        }
        if constexpr (ALIGN_EPI) { if (wr == 0) PG8_BAR; }
        if constexpr (!Epi::AFTER_DRAIN) { E(acc, cur, wr, wc, fr, fq); S.done(cur); }
        if (!has_next) break;
#pragma unroll
        for (int a = 0; a < 2; ++a)
#pragma unroll
            for (int b = 0; b < 2; ++b)
#pragma unroll
                for (int m = 0; m < 4; ++m)
#pragma unroll
                    for (int n = 0; n < 2; ++n) acc[a][b][m][n] = (f32x4){0.f, 0.f, 0.f, 0.f};
        cur = nxt; cA = nA; cB = nB; ++ui;
        if constexpr (ALIGN_EPI) { if (wr == 1) PG8_BAR; }
    }
    PG8_WAIT_V(0);
    if constexpr (!ALIGN_EPI) { if (wr == 0) PG8_BAR; }
    PG8_BAR;
    if constexpr (Epi::AFTER_DRAIN) { E.fused(acc, cur, wr, wc, fr, fq, lds, wid, lane); S.done(cur); }
#undef PG8_SA
#undef PG8_SB
#undef PG8_STAGE
#undef PG8_LDA
#undef PG8_LDB
#undef PG8_MMA
#undef PG8_WAIT_V
#undef PG8_WAIT_L
#undef PG8_BAR
#undef PG8_SCHED
}
}

template <class Epi, bool SS_UNIFORM> struct EpiWrap {
    static constexpr bool PERM = true, AFTER_DRAIN = false;
    Epi e;
    __device__ __forceinline__ void operator()(const pg8::f32x4 (&acc)[2][2][4][2], const pg8::Unit& u, int wr, int wc, int fr, int fq) const {
#pragma unroll
        for (int ai = 0; ai < 2; ++ai)
#pragma unroll
            for (int m = 0; m < 4; ++m) {
                const int row = u.pm * 256 + ai * 128 + wr * 64 + m * 16 + fr;
                float stot = 0.f;
#pragma unroll
                for (int bj = 0; bj < 2; ++bj) {
                    const int c8u = u.pn * 256 + bj * 128 + wc * 32, c8 = c8u + 8 * fq;
                    const float v[8] = {acc[ai][bj][m][0][0], acc[ai][bj][m][0][1], acc[ai][bj][m][0][2], acc[ai][bj][m][0][3], acc[ai][bj][m][1][0], acc[ai][bj][m][1][1], acc[ai][bj][m][1][2], acc[ai][bj][m][1][3]};
                    float s = e.apply(row, c8, v);
                    if (SS_UNIFORM) stot += s;
                    else { float* sp = e.ss_ptr(c8u); if (sp) { s += __shfl_xor(s, 16); s += __shfl_xor(s, 32); if (fq == 0) atomicAdd(sp + row, s); } }
                }
                if (SS_UNIFORM) { float* sp = e.ss_ptr(0); stot += __shfl_xor(stot, 16); stot += __shfl_xor(stot, 32); if (fq == 0) atomicAdd(sp + row, stot); }
                asm volatile("" ::: "memory");
            }
    }
};
template <class Epi, bool SS_UNIFORM>
__device__ __forceinline__ void run_gemm(unsigned char* lds, const bf16_t* A, const bf16_t* Bt, int Mr, int N, int K, const Epi& e) {
    asm volatile("" : "+s"(K));
    pg8::Gemm g{A, Bt, Mr, N, K}; pg8::StaticOrder S; S.init(Mr, N, (int)gridDim.x, (int)blockIdx.x);
    EpiWrap<Epi, SS_UNIFORM> E{e};
    pg8::gemm_phase<EpiWrap<Epi, SS_UNIFORM>, pg8::StaticOrder, true, true>((PG8_LAS unsigned char*)lds, g, S, E);
}

template <class Epi>
__global__ void __launch_bounds__(256) naive_gemm(const bf16_t* __restrict__ A, const bf16_t* __restrict__ Bt, int Mr, int N, int K, Epi E) {
    const long t = (long)blockIdx.x * 256 + threadIdx.x; const int ng = N / 8; const long row = t / ng; const int c8 = (int)(t % ng) * 8;
    if (row >= Mr) return;
    float acc[8] = {0.f, 0.f, 0.f, 0.f, 0.f, 0.f, 0.f, 0.f};
    const bf16_t* a = A + (size_t)row * K; const bf16_t* b = Bt + (size_t)c8 * K;
    for (int k = 0; k < K; k += 8) {
        const u32x4 av = *(const u32x4*)(a + k);
        float af[8] = {__uint_as_float(av.x << 16), __uint_as_float(av.x & 0xffff0000u), __uint_as_float(av.y << 16), __uint_as_float(av.y & 0xffff0000u),
                       __uint_as_float(av.z << 16), __uint_as_float(av.z & 0xffff0000u), __uint_as_float(av.w << 16), __uint_as_float(av.w & 0xffff0000u)};
#pragma unroll
        for (int j = 0; j < 8; ++j) {
            const u32x4 bv = *(const u32x4*)(b + (size_t)j * K + k);
            acc[j] += af[0] * __uint_as_float(bv.x << 16) + af[1] * __uint_as_float(bv.x & 0xffff0000u) + af[2] * __uint_as_float(bv.y << 16) + af[3] * __uint_as_float(bv.y & 0xffff0000u)
                    + af[4] * __uint_as_float(bv.z << 16) + af[5] * __uint_as_float(bv.z & 0xffff0000u) + af[6] * __uint_as_float(bv.w << 16) + af[7] * __uint_as_float(bv.w & 0xffff0000u);
        }
    }
    const float s = E.apply((int)row, c8, acc); float* sp = E.ss_ptr(c8);
    if (sp) atomicAdd(sp + row, s);
}
__device__ __forceinline__ float dot8(const float* q, const bf16_t* k) {
    const u32x4 kv = *(const u32x4*)k;
    return q[0] * __uint_as_float(kv.x << 16) + q[1] * __uint_as_float(kv.x & 0xffff0000u) + q[2] * __uint_as_float(kv.y << 16) + q[3] * __uint_as_float(kv.y & 0xffff0000u)
         + q[4] * __uint_as_float(kv.z << 16) + q[5] * __uint_as_float(kv.z & 0xffff0000u) + q[6] * __uint_as_float(kv.w << 16) + q[7] * __uint_as_float(kv.w & 0xffff0000u);
}
__global__ void __launch_bounds__(64) naive_diff_attn(const bf16_t* __restrict__ Qd, const bf16_t* __restrict__ Kd, const bf16_t* __restrict__ Vd, const int* __restrict__ pos,
                                                      const float* __restrict__ rel_bias, const float* lq1, const float* lk1, const float* lq2, const float* lk2,
                                                      const float* __restrict__ subln, bf16_t* __restrict__ MIX) {
    const int q = blockIdx.x, h = blockIdx.y, b = blockIdx.z, lane = threadIdx.x;
    __shared__ float qs[128];
    const size_t rowq = (size_t)b * SEQ + q;
    qs[lane] = bf2f(Qd[rowq * 512 + h * 128 + lane]); qs[64 + lane] = bf2f(Qd[rowq * 512 + h * 128 + 64 + lane]);
    __syncthreads();
    const float lam = expf(wave_sum(lq1[lane] * lk1[lane])) - expf(wave_sum(lq2[lane] * lk2[lane])) + LAMBDA_INIT;
    const int pq = pos[q];
    float m1 = -1e30f, m2 = -1e30f, l1 = 0.f, l2 = 0.f, o1a = 0.f, o1b = 0.f, o2a = 0.f, o2b = 0.f;
    for (int c = 0; c < SEQ / 64; ++c) {
        const int j = c * 64 + lane; const int dist = pq - pos[j];
        if (__all(dist < 0)) continue;
        const bf16_t* kr = Kd + ((size_t)b * SEQ + j) * 512 + h * 128;
        float s1 = 0.f, s2 = 0.f;
#pragma unroll
        for (int d = 0; d < 64; d += 8) { s1 += dot8(qs + d, kr + d); s2 += dot8(qs + 64 + d, kr + 64 + d); }
        const float bias = rel_bias[t5_bucket(dist) * 4 + h] * LOG2E;
        s1 += bias; s2 += bias;
        if (dist < 0) { s1 = -__builtin_inff(); s2 = -__builtin_inff(); }
        const float mn1 = fmaxf(m1, wave_max(s1)), mn2 = fmaxf(m2, wave_max(s2));
        const float al1 = exp2f(m1 - mn1), al2 = exp2f(m2 - mn2);
        const float p1 = exp2f(s1 - mn1), p2 = exp2f(s2 - mn2);
        l1 = l1 * al1 + wave_sum(p1); l2 = l2 * al2 + wave_sum(p2); m1 = mn1; m2 = mn2;
        o1a *= al1; o1b *= al1; o2a *= al2; o2b *= al2;
        const bf16_t* vr = Vd + ((size_t)b * SEQ + c * 64) * 512 + h * 128 + lane;
        for (int jj = 0; jj < 64; ++jj) {
            const float pj1 = __shfl(p1, jj), pj2 = __shfl(p2, jj);
            const float va = bf2f(vr[(size_t)jj * 512]), vb = bf2f(vr[(size_t)jj * 512 + 64]);
            o1a += pj1 * va; o1b += pj1 * vb; o2a += pj2 * va; o2b += pj2 * vb;
        }
    }
    const float oa = o1a / l1 - lam * (o2a / l2), ob = o1b / l1 - lam * (o2b / l2);
    const float r = rsqrtf(wave_sum(oa * oa + ob * ob) * (1.f / 128.f) + EPS) * (1.f - LAMBDA_INIT);
    bf16_t* o = MIX + rowq * 1024 + h * 128;
    o[lane] = (bf16_t)(cvt_pk_bf16(oa * r * subln[lane], 0.f) & 0xffffu); o[64 + lane] = (bf16_t)(cvt_pk_bf16(ob * r * subln[64 + lane], 0.f) & 0xffffu);
}
__global__ void __launch_bounds__(64) naive_mla_attn(const bf16_t* __restrict__ Qn, const bf16_t* __restrict__ Qp, const bf16_t* __restrict__ Kn, const bf16_t* __restrict__ KPE,
                                                     const bf16_t* __restrict__ Vm, const int* __restrict__ pos, bf16_t* __restrict__ MIX) {
    const int q = blockIdx.x, h = blockIdx.y, b = blockIdx.z, lane = threadIdx.x;
    __shared__ float qs[192];
    const size_t rowq = (size_t)b * SEQ + q;
    qs[lane] = bf2f(Qn[rowq * 512 + h * 128 + lane]); qs[64 + lane] = bf2f(Qn[rowq * 512 + h * 128 + 64 + lane]); qs[128 + lane] = bf2f(Qp[rowq * 256 + h * 64 + lane]);
    __syncthreads();
    const int pq = pos[q];
    float m1 = -1e30f, l1 = 0.f, oa = 0.f, ob = 0.f;
    for (int c = 0; c < SEQ / 64; ++c) {
        const int j = c * 64 + lane; const int dist = pq - pos[j];
        if (__all(dist < 0)) continue;
        const bf16_t* kr = Kn + ((size_t)b * SEQ + j) * 512 + h * 128; const bf16_t* kp = KPE + ((size_t)b * SEQ + j) * 64;
        float s1 = 0.f;
#pragma unroll
        for (int d = 0; d < 128; d += 8) s1 += dot8(qs + d, kr + d);
#pragma unroll
        for (int d = 0; d < 64; d += 8) s1 += dot8(qs + 128 + d, kp + d);
        if (dist < 0) s1 = -__builtin_inff();
        const float mn1 = fmaxf(m1, wave_max(s1)); const float al1 = exp2f(m1 - mn1); const float p1 = exp2f(s1 - mn1);
        l1 = l1 * al1 + wave_sum(p1); m1 = mn1; oa *= al1; ob *= al1;
        const bf16_t* vr = Vm + ((size_t)b * SEQ + c * 64) * 512 + h * 128 + lane;
        for (int jj = 0; jj < 64; ++jj) { const float pj = __shfl(p1, jj); oa += pj * bf2f(vr[(size_t)jj * 512]); ob += pj * bf2f(vr[(size_t)jj * 512 + 64]); }
    }
    bf16_t* o = MIX + rowq * 1024 + 512 + h * 128;
    o[lane] = (bf16_t)(cvt_pk_bf16(oa / l1, 0.f) & 0xffffu); o[64 + lane] = (bf16_t)(cvt_pk_bf16(ob / l1, 0.f) & 0xffffu);
}

#define LAS __attribute__((address_space(3)))
constexpr int NWAVES = 8, NTHREADS = NWAVES * 64;
constexpr int LDS_BYTES = 147456;
struct Args {
    const float* x; const int* pos; const float* rel_bias; const float* norm_attn; const float* w_in;
    const float *lq1, *lk1, *lq2, *lk2; const float* subln; const float* q_norm; const float* w_uq; const float* kv_norm; const float* w_ukv;
    const float* w_out; const float* norm_mlp; const float* w1; const float* w2; const float* norm_final;
    float* out; unsigned char* ws; int ph_lo, ph_hi;
};
struct Frame { int tid, lane, wave, G, vcu; };

template <class Map>
__device__ __forceinline__ void p0_transpose_item(const float* __restrict__ W, int K, int Nsrc, bf16_t* __restrict__ WT, const float* __restrict__ gain, float* scr, int item, int nblk, int lane, Map map) {
    const int kb = item / nblk, nb = item % nblk, k0 = 64 * kb, n0 = 32 * nb;
    const int src = map(n0 + (lane & 31));
#pragma unroll 8
    for (int i = 0; i < 32; ++i) { const int kk = 2 * i + (lane >> 5); float v = 0.f; if (src >= 0) { v = W[(size_t)(k0 + kk) * Nsrc + src]; if (gain) v *= gain[k0 + kk]; } scr[kk * 33 + (lane & 31)] = v; }
    asm volatile("s_waitcnt lgkmcnt(0)" ::: "memory");
    const int c = lane & 7;
#pragma unroll
    for (int j = 0; j < 4; ++j) { const int n = (lane >> 3) + 8 * j; const float* s = scr + (8 * c) * 33 + n;
        u32x4 o; o.x = cvt_pk_bf16(s[0 * 33], s[1 * 33]); o.y = cvt_pk_bf16(s[2 * 33], s[3 * 33]); o.z = cvt_pk_bf16(s[4 * 33], s[5 * 33]); o.w = cvt_pk_bf16(s[6 * 33], s[7 * 33]);
        *(u32x4*)(WT + (size_t)(n0 + n) * K + k0 + 8 * c) = o; }
    asm volatile("s_waitcnt lgkmcnt(0)" ::: "memory");
}
struct MapId { __device__ int operator()(int n) const { return n; } };
struct MapWin { __device__ int operator()(int n) const { return n < 2176 ? n : (n < 2240 ? 2176 + rope_orig(n - 2176) : -1); } };
struct MapWuq { __device__ int operator()(int n) const { if (n < 512) return (n >> 7) * 192 + (n & 127); const int p = n - 512; return (p >> 6) * 192 + 128 + rope_orig(p & 63); } };
struct MapWukv { __device__ int operator()(int n) const { if (n < 512) return (n >> 7) * 256 + (n & 127); const int p = n - 512; return (p >> 7) * 256 + 128 + (p & 127); } };

__device__ __forceinline__ void p0_prologue(const Args& a, const Frame& F, unsigned char* lds) {
    float* scr = (float*)(lds + F.wave * 16384);
    const int gw = F.vcu * NWAVES + F.wave, NGW = F.G * NWAVES;
    unsigned char* ws = a.ws;
    { f32x4* z = (f32x4*)(ws + WS_SSQ); for (int i = F.vcu * NTHREADS + F.tid; i < 4 * M / 4; i += F.G * NTHREADS) z[i] = (f32x4){0.f, 0.f, 0.f, 0.f}; }
    { f32x2* cs = (f32x2*)(ws + WS_CS);
      for (int i = F.vcu * NTHREADS + F.tid; i < SEQ * 32; i += F.G * NTHREADS) { const int s = i >> 5, f = i & 31;
          const float inv = exp2f(-(float)f * (13.287712379549449f / 32.f)); const float ang = (float)a.pos[s] * inv; float sn, cn; sincos_acc(ang, sn, cn); cs[i] = (f32x2){cn, sn}; } }
    constexpr int I_IN = (DM / 64) * (NINP / 32), I_UQ = (384 / 64) * (768 / 32), I_UKV = (256 / 64) * (1024 / 32), I_OUT = (DM / 64) * (DM / 32), I_1 = (DM / 64) * (FF / 32), I_2 = (FF / 64) * (DM / 32);
    constexpr int NITEMS = I_IN + I_UQ + I_UKV + I_OUT + I_1 + I_2;
    for (int it = gw; it < NITEMS; it += NGW) {
        int r = it;
        if (r < I_IN) { p0_transpose_item(a.w_in, DM, NIN, (bf16_t*)(ws + WS_WIN), nullptr, scr, r, NINP / 32, F.lane, MapWin()); continue; } r -= I_IN;
        if (r < I_UQ) { p0_transpose_item(a.w_uq, 384, 768, (bf16_t*)(ws + WS_WUQ), a.q_norm, scr, r, 768 / 32, F.lane, MapWuq()); continue; } r -= I_UQ;
        if (r < I_UKV) { p0_transpose_item(a.w_ukv, 256, 1024, (bf16_t*)(ws + WS_WUKV), a.kv_norm, scr, r, 1024 / 32, F.lane, MapWukv()); continue; } r -= I_UKV;
        if (r < I_OUT) { p0_transpose_item(a.w_out, DM, DM, (bf16_t*)(ws + WS_WOUT), nullptr, scr, r, DM / 32, F.lane, MapId()); continue; } r -= I_OUT;
        if (r < I_1) { p0_transpose_item(a.w1, DM, FF, (bf16_t*)(ws + WS_W1), a.norm_mlp, scr, r, FF / 32, F.lane, MapId()); continue; } r -= I_1;
        p0_transpose_item(a.w2, FF, DM, (bf16_t*)(ws + WS_W2), nullptr, scr, r, DM / 32, F.lane, MapId());
    }
    { bf16_t* XN = (bf16_t*)(ws + WS_XN);
      f32x4 g[4];
#pragma unroll
      for (int j = 0; j < 4; ++j) g[j] = ((const f32x4*)a.norm_attn)[F.lane + 64 * j];
      for (int m = gw; m < M; m += NGW) {
          const f32x4* xr = (const f32x4*)(a.x + (size_t)m * DM) + F.lane; f32x4 v[4]; float s = 0.f;
#pragma unroll
          for (int j = 0; j < 4; ++j) { v[j] = xr[64 * j]; s += (v[j].x * v[j].x + v[j].y * v[j].y) + (v[j].z * v[j].z + v[j].w * v[j].w); }
          const float rs = rsqrtf(wave_sum(s) * (1.f / DM) + EPS);
          u32x2* o8 = (u32x2*)(XN + (size_t)m * DM) + F.lane;
#pragma unroll
          for (int j = 0; j < 4; ++j) { u32x2 w; w.x = cvt_pk_bf16(v[j].x * rs * g[j].x, v[j].y * rs * g[j].y); w.y = cvt_pk_bf16(v[j].z * rs * g[j].z, v[j].w * rs * g[j].w); o8[64 * j] = w; }
      } }
}
__device__ __forceinline__ void p7_final_norm(const Args& a, const Frame& F) {
    const int gw = F.vcu * NWAVES + F.wave, NGW = F.G * NWAVES;
    const float* ss2 = (const float*)(a.ws + WS_SS2);
    f32x4 g[4];
#pragma unroll
    for (int j = 0; j < 4; ++j) g[j] = ((const f32x4*)a.norm_final)[F.lane + 64 * j];
    for (int m = gw; m < M; m += NGW) {
        f32x4* xr = (f32x4*)(a.out + (size_t)m * DM) + F.lane; const float rs = rsqrtf(ss2[m] * (1.f / DM) + EPS);
#pragma unroll
        for (int j = 0; j < 4; ++j) { f32x4 v = xr[64 * j]; v = v * rs * g[j]; xr[64 * j] = v; }
    }
}

__global__ void __launch_bounds__(NTHREADS, 2) mk_fwd(Args args) {
    extern __shared__ __attribute__((aligned(16))) unsigned char lds[];
    Frame F; F.tid = threadIdx.x; F.lane = F.tid & 63; F.wave = __builtin_amdgcn_readfirstlane(F.tid >> 6); F.G = gridDim.x;
    { const int bx = blockIdx.x; F.vcu = (F.G % 8 == 0) ? (bx % 8) * (F.G / 8) + bx / 8 : bx; }
    const int lo = args.ph_lo, hi = args.ph_hi;
#ifndef PHMASK
#define PHMASK 0xffu
#endif
#define IN(k) (((PHMASK >> (k)) & 1u) && lo <= (k) && (k) < hi)
    unsigned char* ws = args.ws;
    bf16_t *XN = (bf16_t*)(ws + WS_XN), *MIX = (bf16_t*)(ws + WS_MIX), *Qd = (bf16_t*)(ws + WS_QD), *Kd = (bf16_t*)(ws + WS_KD), *Vd = (bf16_t*)(ws + WS_VD), *CQ = (bf16_t*)(ws + WS_CQ), *CKV = (bf16_t*)(ws + WS_CKV),
           *KPE = (bf16_t*)(ws + WS_KPE), *Qn = (bf16_t*)(ws + WS_QN), *Qp = (bf16_t*)(ws + WS_QP), *Kn = (bf16_t*)(ws + WS_KN), *Vm = (bf16_t*)(ws + WS_VM), *X1b = (bf16_t*)(ws + WS_X1B), *H = (bf16_t*)(ws + WS_H);
    float *ssq = (float*)(ws + WS_SSQ), *sskv = (float*)(ws + WS_SSKV), *ss1 = (float*)(ws + WS_SS1), *ss2 = (float*)(ws + WS_SS2);
    const f32x2* cs = (const f32x2*)(ws + WS_CS);
    if (IN(0)) p0_prologue(args, F, lds);
    if (IN(1)) { EpiG1 E{Qd, Kd, Vd, CQ, CKV, KPE, ssq, sskv, cs}; run_gemm<EpiG1, false>(lds, XN, (const bf16_t*)(ws + WS_WIN), M, NINP, DM, E); }
    if (IN(2)) {
#ifndef NO_GQ
                 { EpiQ E{Qn, Qp, ssq, cs}; run_gemm<EpiQ, false>(lds, CQ, (const bf16_t*)(ws + WS_WUQ), M, 768, 384, E); }
#endif
#ifndef NO_GKV
                 { EpiKV E{Kn, Vm, sskv}; run_gemm<EpiKV, false>(lds, CKV, (const bf16_t*)(ws + WS_WUKV), M, 1024, 256, E); }
#endif
    }
    if (IN(4)) { EpiOut E{args.x, args.out, X1b, ss1}; run_gemm<EpiOut, true>(lds, MIX, (const bf16_t*)(ws + WS_WOUT), M, DM, DM, E); }
    if (IN(5)) { EpiUp E{H, ss1}; run_gemm<EpiUp, false>(lds, X1b, (const bf16_t*)(ws + WS_W1), M, FF, DM, E); }
    if (IN(6)) { EpiDown E{args.out, ss2}; run_gemm<EpiDown, true>(lds, H, (const bf16_t*)(ws + WS_W2), M, DM, FF, E); }
    if (IN(7)) p7_final_norm(args, F);
#undef IN
}

#ifndef FASTMASK
#define FASTMASK 0x76u
#endif
extern "C" void kernel_launch(void* const* d_in, const int* in_sizes, int n_in, void* d_out, int out_size, void* d_ws, size_t ws_size, hipStream_t stream) {
    static int grid = 0;
    if (grid == 0) {
        if (n_in != 19 || in_sizes[0] != M * DM || out_size != M * DM || ws_size < WS_END) { fprintf(stderr, "kernel_launch: unexpected shapes (n_in %d, in0 %d, out %d, ws %zu)\n", n_in, n_in > 0 ? in_sizes[0] : -1, out_size, ws_size); grid = -1; return; }
        int dev = 0, cus = 0; (void)hipGetDevice(&dev); if (hipDeviceGetAttribute(&cus, hipDeviceAttributeMultiprocessorCount, dev) != hipSuccess || cus <= 0) cus = 256;
        (void)hipFuncSetAttribute((const void*)mk_fwd, hipFuncAttributeMaxDynamicSharedMemorySize, LDS_BYTES);
        grid = cus;
    }
    if (grid < 0) return;
    Args a{};
    a.x = (const float*)d_in[0]; a.pos = (const int*)d_in[1]; a.rel_bias = (const float*)d_in[2]; a.norm_attn = (const float*)d_in[3]; a.w_in = (const float*)d_in[4];
    a.lq1 = (const float*)d_in[5]; a.lk1 = (const float*)d_in[6]; a.lq2 = (const float*)d_in[7]; a.lk2 = (const float*)d_in[8]; a.subln = (const float*)d_in[9];
    a.q_norm = (const float*)d_in[10]; a.w_uq = (const float*)d_in[11]; a.kv_norm = (const float*)d_in[12]; a.w_ukv = (const float*)d_in[13];
    a.w_out = (const float*)d_in[14]; a.norm_mlp = (const float*)d_in[15]; a.w1 = (const float*)d_in[16]; a.w2 = (const float*)d_in[17]; a.norm_final = (const float*)d_in[18];
    a.out = (float*)d_out; a.ws = (unsigned char*)d_ws;
    unsigned char* ws = (unsigned char*)d_ws;
    bf16_t *XN = (bf16_t*)(ws + WS_XN), *MIX = (bf16_t*)(ws + WS_MIX), *Qd = (bf16_t*)(ws + WS_QD), *Kd = (bf16_t*)(ws + WS_KD), *Vd = (bf16_t*)(ws + WS_VD), *CQ = (bf16_t*)(ws + WS_CQ), *CKV = (bf16_t*)(ws + WS_CKV),
           *KPE = (bf16_t*)(ws + WS_KPE), *Qn = (bf16_t*)(ws + WS_QN), *Qp = (bf16_t*)(ws + WS_QP), *Kn = (bf16_t*)(ws + WS_KN), *Vm = (bf16_t*)(ws + WS_VM), *X1b = (bf16_t*)(ws + WS_X1B), *H = (bf16_t*)(ws + WS_H);
    float *ssq = (float*)(ws + WS_SSQ), *sskv = (float*)(ws + WS_SSKV), *ss1 = (float*)(ws + WS_SS1), *ss2 = (float*)(ws + WS_SS2);
    const f32x2* cs = (const f32x2*)(ws + WS_CS);
    auto launch_phase = [&](int p) { a.ph_lo = p; a.ph_hi = p + 1; hipLaunchKernelGGL(mk_fwd, dim3(grid), dim3(NTHREADS), LDS_BYTES, stream, a); };
    constexpr unsigned FAST = FASTMASK;
    launch_phase(0);
    if (FAST & 2) launch_phase(1);
    else { EpiG1 E{Qd, Kd, Vd, CQ, CKV, KPE, ssq, sskv, cs}; const long nt = (long)M * (NINP / 8); hipLaunchKernelGGL(naive_gemm<EpiG1>, dim3((unsigned)((nt + 255) / 256)), dim3(256), 0, stream, XN, (const bf16_t*)(ws + WS_WIN), M, NINP, DM, E); }
    if (FAST & 4) launch_phase(2);
    else { { EpiQ E{Qn, Qp, ssq, cs}; const long nt = (long)M * (768 / 8); hipLaunchKernelGGL(naive_gemm<EpiQ>, dim3((unsigned)((nt + 255) / 256)), dim3(256), 0, stream, CQ, (const bf16_t*)(ws + WS_WUQ), M, 768, 384, E); }
           { EpiKV E{Kn, Vm, sskv}; const long nt = (long)M * (1024 / 8); hipLaunchKernelGGL(naive_gemm<EpiKV>, dim3((unsigned)((nt + 255) / 256)), dim3(256), 0, stream, CKV, (const bf16_t*)(ws + WS_WUKV), M, 1024, 256, E); } }
    hipLaunchKernelGGL(naive_diff_attn, dim3(SEQ, 4, BATCH), dim3(64), 0, stream, Qd, Kd, Vd, a.pos, a.rel_bias, a.lq1, a.lk1, a.lq2, a.lk2, a.subln, MIX);
    hipLaunchKernelGGL(naive_mla_attn, dim3(SEQ, 4, BATCH), dim3(64), 0, stream, Qn, Qp, Kn, KPE, Vm, a.pos, MIX);
    if (FAST & 16) launch_phase(4);
    else { EpiOut E{a.x, a.out, X1b, ss1}; const long nt = (long)M * (DM / 8); hipLaunchKernelGGL(naive_gemm<EpiOut>, dim3((unsigned)((nt + 255) / 256)), dim3(256), 0, stream, MIX, (const bf16_t*)(ws + WS_WOUT), M, DM, DM, E); }
    if (FAST & 32) launch_phase(5);
    else { EpiUp E{H, ss1}; const long nt = (long)M * (FF / 8); hipLaunchKernelGGL(naive_gemm<EpiUp>, dim3((unsigned)((nt + 255) / 256)), dim3(256), 0, stream, X1b, (const bf16_t*)(ws + WS_W1), M, FF, DM, E); }
    if (FAST & 64) launch_phase(6);
    else { EpiDown E{a.out, ss2}; const long nt = (long)M * (DM / 8); hipLaunchKernelGGL(naive_gemm<EpiDown>, dim3((unsigned)((nt + 255) / 256)), dim3(256), 0, stream, H, (const bf16_t*)(ws + WS_W2), M, DM, FF, E); }
    launch_phase(7);
}
```

```cpp
#include <hip/hip_runtime.h>
#include <cstdint>
#include <cstdio>

constexpr int BATCH = 8, SEQ = 4096, DM = 1024, M = BATCH * SEQ;
constexpr int NIN = 2240, NINP = 2304;
constexpr int FF = 4096;
constexpr float EPS = 1e-6f;
constexpr float LOG2E = 1.4426950408889634f;
constexpr float QSCALE_D = 0.125f * LOG2E;
constexpr float QSCALE_M = 0.07216878364870322f * LOG2E;
constexpr float LAMBDA_INIT = 0.2f;

typedef unsigned short bf16_t;
typedef float f32x4 __attribute__((ext_vector_type(4)));
typedef float f32x2 __attribute__((ext_vector_type(2)));
typedef unsigned u32x4 __attribute__((ext_vector_type(4)));
typedef unsigned u32x2 __attribute__((ext_vector_type(2)));

constexpr size_t MiB = 1u << 20;
constexpr size_t WS_SSQ = 0, WS_SSKV = 128 * 1024, WS_SS1 = 256 * 1024, WS_SS2 = 384 * 1024;
constexpr size_t WS_CS = 1 * MiB;
constexpr size_t WS_WIN = 2 * MiB;
constexpr size_t WS_WUQ = 7 * MiB;
constexpr size_t WS_WUKV = 8 * MiB;
constexpr size_t WS_WOUT = 9 * MiB;
constexpr size_t WS_W1 = 11 * MiB;
constexpr size_t WS_W2 = 19 * MiB;
constexpr size_t WS_XN = 32 * MiB;
constexpr size_t WS_MIX = WS_XN;
constexpr size_t WS_QD = 96 * MiB, WS_KD = 128 * MiB, WS_VD = 160 * MiB;
constexpr size_t WS_CQ = 192 * MiB;
constexpr size_t WS_CKV = 216 * MiB;
constexpr size_t WS_KPE = 232 * MiB;
constexpr size_t WS_QN = 236 * MiB;
constexpr size_t WS_QP = 268 * MiB;
constexpr size_t WS_KN = 284 * MiB;
constexpr size_t WS_VM = 316 * MiB;
constexpr size_t WS_X1B = 348 * MiB;
constexpr size_t WS_H = 32 * MiB;
constexpr size_t WS_END = 412 * MiB;

__device__ __forceinline__ float bf2f(bf16_t b) { return __uint_as_float((unsigned)b << 16); }
__device__ __forceinline__ unsigned cvt_pk_bf16(float lo, float hi) { unsigned r; asm("v_cvt_pk_bf16_f32 %0, %1, %2" : "=v"(r) : "v"(lo), "v"(hi)); return r; }
__device__ __forceinline__ float wave_sum(float v) {
#pragma unroll
    for (int o = 1; o < 64; o <<= 1) v += __shfl_xor(v, o);
    return v;
}
__device__ __forceinline__ float wave_max(float v) {
#pragma unroll
    for (int o = 1; o < 64; o <<= 1) v = fmaxf(v, __shfl_xor(v, o));
    return v;
}
__device__ __forceinline__ void store8_bf16(bf16_t* p, const float (&v)[8], float s) {
    u32x4 w; w.x = cvt_pk_bf16(v[0] * s, v[1] * s); w.y = cvt_pk_bf16(v[2] * s, v[3] * s); w.z = cvt_pk_bf16(v[4] * s, v[5] * s); w.w = cvt_pk_bf16(v[6] * s, v[7] * s);
    *(u32x4*)p = w;
}
__device__ __forceinline__ int t5_bucket(int dist) {
    const int n = dist > 0 ? dist : 0;
    if (n < 16) return n;
    const float nf = (float)n;
    const int large = 16 + (int)(logf(nf / 16.f) / 2.0794415416798357f * 16.f);
    return large < 31 ? large : 31;
}
__device__ __forceinline__ void sincos_acc(float ang, float& s, float& c) {
    const double a = (double)ang; const double k = rint(a * 0.63661977236758134308);
    double r = fma(-k, 1.57079632679489655800, a); r = fma(-k, 6.12323399573676603587e-17, r);
    const float x = (float)r, x2 = x * x;
    const float sp = x + x * x2 * (-1.6666654611e-1f + x2 * (8.3321608736e-3f + x2 * (-1.9515295891e-4f)));
    const float cp = 1.0f - 0.5f * x2 + x2 * x2 * (4.166664568298827e-2f + x2 * (-1.388731625493765e-3f + x2 * 2.443315711809948e-5f));
    const int q = ((int)k) & 3;
    const float s0 = (q & 1) ? cp : sp, c0 = (q & 1) ? sp : cp;
    s = (q & 2) ? -s0 : s0; c = ((q == 1) || (q == 2)) ? -c0 : c0;
}

__host__ __device__ __forceinline__ int rope_orig(int p) { return 32 * ((p >> 2) & 1) + 16 * (p >> 5) + 4 * ((p >> 3) & 3) + (p & 3); }
__device__ __forceinline__ void rope8_store(bf16_t* dst  , int p8, const f32x2* cs_row, const float (&v)[8], float sc) {
    const int i0 = (p8 >> 5) * 16 + ((p8 >> 3) & 3) * 4;
    float o1[4], o2[4];
#pragma unroll
    for (int e = 0; e < 4; ++e) { const f32x2 t = cs_row[i0 + e]; const float x1 = v[e] * sc, x2 = v[4 + e] * sc; o1[e] = x1 * t.x - x2 * t.y; o2[e] = x1 * t.y + x2 * t.x; }
    u32x2 a, b; a.x = cvt_pk_bf16(o1[0], o1[1]); a.y = cvt_pk_bf16(o1[2], o1[3]); b.x = cvt_pk_bf16(o2[0], o2[1]); b.y = cvt_pk_bf16(o2[2], o2[3]);
    *(u32x2*)(dst + i0) = a; *(u32x2*)(dst + 32 + i0) = b;
}
struct EpiG1 {
    bf16_t *Qd, *Kd, *Vd, *CQ, *CKV, *KPE; float *ssq, *sskv; const f32x2* cs;
    __device__ __forceinline__ float* ss_ptr(int c8) const { return (c8 >= 1536 && c8 < 1920) ? ssq : (c8 >= 1920 && c8 < 2176) ? sskv : nullptr; }
    __device__ __forceinline__ float apply(int row, int c8, const float (&v)[8]) const {
        if (c8 < 512) { store8_bf16(Qd + (size_t)row * 512 + c8, v, QSCALE_D); return 0.f; }
        if (c8 < 1024) { store8_bf16(Kd + (size_t)row * 512 + (c8 - 512), v, 1.f); return 0.f; }
        if (c8 < 1536) { store8_bf16(Vd + (size_t)row * 512 + (c8 - 1024), v, 1.f); return 0.f; }
        if (c8 < 2176) {
            float s = 0.f;
#pragma unroll
            for (int j = 0; j < 8; ++j) s += v[j] * v[j];
            if (c8 < 1920) store8_bf16(CQ + (size_t)row * 384 + (c8 - 1536), v, 1.f); else store8_bf16(CKV + (size_t)row * 256 + (c8 - 1920), v, 1.f);
            return s;
        }
        if (c8 < 2240) rope8_store(KPE + (size_t)row * 64, c8 - 2176, cs + (size_t)(row & (SEQ - 1)) * 32, v, 1.f);
        return 0.f;
    }
};
struct EpiQ {
    bf16_t *Qn, *Qp; const float* ssq; const f32x2* cs;
    __device__ __forceinline__ float* ss_ptr(int) const { return nullptr; }
    __device__ __forceinline__ float apply(int row, int c8, const float (&v)[8]) const {
        const float rs = rsqrtf(ssq[row] * (1.f / 384.f) + EPS) * QSCALE_M;
        if (c8 < 512) { store8_bf16(Qn + (size_t)row * 512 + c8, v, rs); return 0.f; }
        const int p = c8 - 512;
        rope8_store(Qp + (size_t)row * 256 + (p >> 6) * 64, p & 63, cs + (size_t)(row & (SEQ - 1)) * 32, v, rs);
        return 0.f;
    }
};
struct EpiKV {
    bf16_t *Kn, *Vm; const float* sskv;
    __device__ __forceinline__ float* ss_ptr(int) const { return nullptr; }
    __device__ __forceinline__ float apply(int row, int c8, const float (&v)[8]) const {
        const float rs = rsqrtf(sskv[row] * (1.f / 256.f) + EPS);
        if (c8 < 512) store8_bf16(Kn + (size_t)row * 512 + c8, v, rs); else store8_bf16(Vm + (size_t)row * 512 + (c8 - 512), v, rs);
        return 0.f;
    }
};
struct EpiOut {
    const float* x; float* X1; bf16_t* X1b; float* ss1;
    __device__ __forceinline__ float* ss_ptr(int) const { return ss1; }
    __device__ __forceinline__ float apply(int row, int c8, const float (&v)[8]) const {
        const size_t off = (size_t)row * DM + c8;
        const f32x4 a = *(const f32x4*)(x + off), b = *(const f32x4*)(x + off + 4);
        float o[8] = {a.x + v[0], a.y + v[1], a.z + v[2], a.w + v[3], b.x + v[4], b.y + v[5], b.z + v[6], b.w + v[7]};
        *(f32x4*)(X1 + off) = (f32x4){o[0], o[1], o[2], o[3]}; *(f32x4*)(X1 + off + 4) = (f32x4){o[4], o[5], o[6], o[7]};
        store8_bf16(X1b + off, o, 1.f);
        float s = 0.f;
#pragma unroll
        for (int j = 0; j < 8; ++j) s += o[j] * o[j];
        return s;
    }
};
struct EpiUp {
    bf16_t* H; const float* ss1;
    __device__ __forceinline__ float* ss_ptr(int) const { return nullptr; }
    __device__ __forceinline__ float apply(int row, int c8, const float (&v)[8]) const {
        const float rs = rsqrtf(ss1[row] * (1.f / 1024.f) + EPS);
        float o[8];
#pragma unroll
        for (int j = 0; j < 8; ++j) { const float t = fmaxf(v[j] * rs, 0.f); o[j] = t * t; }
        store8_bf16(H + (size_t)row * FF + c8, o, 1.f);
        return 0.f;
    }
};
struct EpiDown {
    float* X; float* ss2;
    __device__ __forceinline__ float* ss_ptr(int) const { return ss2; }
    __device__ __forceinline__ float apply(int row, int c8, const float (&v)[8]) const {
        const size_t off = (size_t)row * DM + c8;
        const f32x4 a = *(const f32x4*)(X + off), b = *(const f32x4*)(X + off + 4);
        float o[8] = {a.x + v[0], a.y + v[1], a.z + v[2], a.w + v[3], b.x + v[4], b.y + v[5], b.z + v[6], b.w + v[7]};
        *(f32x4*)(X + off) = (f32x4){o[0], o[1], o[2], o[3]}; *(f32x4*)(X + off + 4) = (f32x4){o[4], o[5], o[6], o[7]};
        float s = 0.f;
#pragma unroll
        for (int j = 0; j < 8; ++j) s += o[j] * o[j];
        return s;
    }
};


namespace pg8 {
#define PG8_LAS __attribute__((address_space(3)))
typedef unsigned short bf16_t;
typedef short bf16x8 __attribute__((ext_vector_type(8)));
typedef float f32x4 __attribute__((ext_vector_type(4)));
typedef unsigned u32x4 __attribute__((ext_vector_type(4)));
constexpr int BM = 256, BK = 64, HALF = 128, HTB = HALF * BK * 2  , STAGE_BYTES = 8 * HTB, NXCD = 8, WGM = 8;

__host__ __device__ __forceinline__ int lds_byte(int r, int c) { const int st = (r >> 4) * 2 + (c >> 5), rr = r & 15, cc = c & 31, ob = rr * 64 + cc * 2; return st * 1024 + (ob ^ (((ob >> 9) & 1) << 5)); }
__host__ __device__ __forceinline__ void stage_rc(int b, int& R, int& C) { const int st = b / 1024, sb = b % 1024, swz = sb ^ (((sb >> 9) & 1) << 5); R = (st >> 1) * 16 + swz / 64; C = (st & 1) * 32 + (swz % 64) / 2; }
__host__ __device__ __forceinline__ int perm32(int rho) { const int n = rho >> 4, i = rho & 15; return 8 * (i >> 2) + 4 * n + (i & 3); }

struct Unit { int pm, pn; };
struct Gemm { const bf16_t* A; const bf16_t* Bt; int M, N, K; };

struct StaticOrder {
    int nM, nN, nwg, G, c;
    __host__ __device__ void init(int M, int N, int G_, int c_) { nM = M / BM; nN = N / BM; nwg = nM * nN; G = G_; c = c_; }
    __host__ __device__ bool next(int i, Unit& u) const {
        const long L = (long)i * G + c; if (L >= nwg) return false;
        int wgid = (int)L; { const int q = nwg / NXCD, r = nwg % NXCD, xcd = wgid % NXCD, off = wgid / NXCD; wgid = (xcd < r ? xcd * (q + 1) : r * (q + 1) + (xcd - r) * q) + off; }
        const int nig = WGM * nN, gid = wgid / nig, fm = gid * WGM, gsz = (nM - fm) < WGM ? (nM - fm) : WGM;
        u.pm = fm + ((wgid % nig) % gsz); u.pn = (wgid % nig) / gsz; return true;
    }
    __device__ __forceinline__ void a_ready(const Unit&) const {}
    __device__ __forceinline__ void done(const Unit&) const {}
};

template <class Epi, class Sched, bool ALIGN_EPI = false, bool SP2 = false>
__device__ __forceinline__ void gemm_phase(PG8_LAS unsigned char* lds, const Gemm g, const Sched& S, const Epi& E) {
    int tid_ = threadIdx.x; asm volatile("" : "+v"(tid_));
    const int tid = tid_, wid = __builtin_amdgcn_readfirstlane(tid >> 6), lane = tid & 63, wr = wid >> 2, wc = wid & 3, fr = lane & 15, fq = lane >> 4;
    const int K = g.K, nt = K / BK;
    unsigned voffA[2], voffB[2];
#pragma unroll
    for (int i = 0; i < 2; ++i) { int R, C; stage_rc(tid * 16 + i * 8192, R, C); const int Rb = Epi::PERM ? ((R & ~31) + perm32(R & 31)) : R;
        voffA[i] = (unsigned)(R * K + C) * 2u; voffB[i] = (unsigned)(Rb * K + C) * 2u; }
    const size_t kstep = (size_t)(BK * 2);
    const size_t hstep = (size_t)HALF * K * 2;
    const size_t tstep = 2 * hstep;
    const unsigned ldsw = (unsigned)wid * 1024u;
    const int aoff = lds_byte(wr * 64 + fr, fq * 8), boff = lds_byte(wc * 32 + fr, fq * 8);
#define PG8_SA(b, h) (((b) * 2 + (h)) * HTB)
#define PG8_SB(b, h) ((4 + (b) * 2 + (h)) * HTB)
#define PG8_STAGE(bufoff, gbase, voff) do { _Pragma("unroll") for (int _i = 0; _i < 2; ++_i) \
        __builtin_amdgcn_global_load_lds((const unsigned*)((const char*)(gbase) + (voff)[_i]), (PG8_LAS unsigned*)(lds + (bufoff) + ldsw + _i * 8192), 16, 0, 0); } while (0)
#define PG8_LDA(dst, b, h) do { _Pragma("unroll") for (int m = 0; m < 4; ++m) _Pragma("unroll") for (int k = 0; k < 2; ++k) dst[m][k] = *(const PG8_LAS bf16x8*)(lds + PG8_SA(b, h) + aoff + m * 2048 + k * 1024); } while (0)
#define PG8_LDB(dst, b, h) do { _Pragma("unroll") for (int n = 0; n < 2; ++n) _Pragma("unroll") for (int k = 0; k < 2; ++k) dst[n][k] = *(const PG8_LAS bf16x8*)(lds + PG8_SB(b, h) + boff + n * 2048 + k * 1024); } while (0)
#define PG8_MMA(ai, bj, At, Bt) do { __builtin_amdgcn_s_setprio(1); _Pragma("unroll") for (int m = 0; m < 4; ++m) _Pragma("unroll") for (int n = 0; n < 2; ++n) _Pragma("unroll") for (int k = 0; k < 2; ++k) \
        acc[ai][bj][m][n] = __builtin_amdgcn_mfma_f32_16x16x32_bf16(Bt[n][k], At[m][k], acc[ai][bj][m][n], 0, 0, 0); __builtin_amdgcn_s_setprio(0); } while (0)
#define PG8_WAIT_V(n) asm volatile("s_waitcnt vmcnt(" #n ")" ::: "memory")
#define PG8_WAIT_L(n) asm volatile("s_waitcnt lgkmcnt(" #n ")" ::: "memory")
#define PG8_BAR __builtin_amdgcn_s_barrier()
#define PG8_SCHED __builtin_amdgcn_sched_barrier(0)
    Unit cur, nxt; int ui = 0;
    if (!S.next(0, cur)) return;
    f32x4 acc[2][2][4][2];
#pragma unroll
    for (int a = 0; a < 2; ++a)
#pragma unroll
        for (int b = 0; b < 2; ++b)
#pragma unroll
            for (int m = 0; m < 4; ++m)
#pragma unroll
                for (int n = 0; n < 2; ++n) acc[a][b][m][n] = (f32x4){0.f, 0.f, 0.f, 0.f};
    bf16x8 At[4][2], B0[2][2], B1[2][2];
    const char* cA = (const char*)g.A + (size_t)cur.pm * tstep; const char* cB = (const char*)g.Bt + (size_t)cur.pn * tstep;
    S.a_ready(cur);
    if constexpr (SP2) {
        PG8_STAGE(PG8_SB(0, 0), cB, voffB); PG8_STAGE(PG8_SB(0, 1), cB + hstep, voffB); PG8_STAGE(PG8_SA(0, 0), cA, voffA); PG8_STAGE(PG8_SA(0, 1), cA + hstep, voffA);
        if (wr == 1) PG8_BAR;
        PG8_WAIT_V(2); PG8_BAR;
        PG8_STAGE(PG8_SB(1, 0), cB + kstep, voffB); PG8_STAGE(PG8_SA(1, 0), cA + kstep, voffA); PG8_STAGE(PG8_SB(1, 1), cB + hstep + kstep, voffB);
        PG8_WAIT_V(6); PG8_BAR;
    } else {
        PG8_STAGE(PG8_SB(0, 0), cB, voffB); PG8_STAGE(PG8_SA(0, 0), cA, voffA); PG8_STAGE(PG8_SB(0, 1), cB + hstep, voffB); PG8_STAGE(PG8_SA(0, 1), cA + hstep, voffA);
        if (wr == 1) PG8_BAR;
        PG8_WAIT_V(4); PG8_BAR;
        PG8_STAGE(PG8_SB(1, 0), cB + kstep, voffB); PG8_STAGE(PG8_SA(1, 0), cA + kstep, voffA); PG8_STAGE(PG8_SB(1, 1), cB + hstep + kstep, voffB);
        PG8_WAIT_V(6); PG8_BAR;
    }
    for (;;) {
        const bool has_next = S.next(ui + 1, nxt);
        const char* nA = has_next ? (const char*)g.A + (size_t)nxt.pm * tstep : cA; const char* nB = has_next ? (const char*)g.Bt + (size_t)nxt.pn * tstep : cB;
        for (int t = 0; t < nt; t += 2) {
            const bool last = (t == nt - 2);
            const char* a1 = cA + (size_t)(t + 1) * kstep;
            const char* a2 = last ? nA : cA + (size_t)(t + 2) * kstep; const char* b2 = last ? nB : cB + (size_t)(t + 2) * kstep;
            const char* a3 = a2 + kstep; const char* b3 = b2 + kstep;
            if (last && has_next) S.a_ready(nxt);
            if constexpr (SP2) {
            PG8_LDB(B0, 0, 0); PG8_LDB(B1, 0, 1); PG8_SCHED; PG8_LDA(At, 0, 0); PG8_STAGE(PG8_SA(1, 1), a1 + hstep, voffA);
            PG8_WAIT_V(8); PG8_WAIT_L(0); PG8_BAR; PG8_MMA(0, 0, At, B0); PG8_MMA(0, 1, At, B1); PG8_BAR; PG8_SCHED;
            PG8_LDA(At, 0, 1); PG8_STAGE(PG8_SB(0, 0), b2, voffB); PG8_STAGE(PG8_SB(0, 1), b2 + hstep, voffB); PG8_STAGE(PG8_SA(0, 0), a2, voffA);
            PG8_WAIT_V(8); PG8_WAIT_L(0); PG8_BAR; PG8_MMA(1, 0, At, B0); PG8_MMA(1, 1, At, B1); PG8_BAR; PG8_SCHED;
            PG8_LDB(B0, 1, 0); PG8_LDB(B1, 1, 1); PG8_SCHED; PG8_LDA(At, 1, 0); PG8_STAGE(PG8_SA(0, 1), a2 + hstep, voffA);
            PG8_WAIT_V(8); PG8_WAIT_L(0); PG8_BAR; PG8_MMA(0, 0, At, B0); PG8_MMA(0, 1, At, B1); PG8_BAR; PG8_SCHED;
            PG8_LDA(At, 1, 1); PG8_STAGE(PG8_SB(1, 0), b3, voffB); PG8_STAGE(PG8_SB(1, 1), b3 + hstep, voffB); PG8_STAGE(PG8_SA(1, 0), a3, voffA);
            PG8_WAIT_V(8); PG8_WAIT_L(0); PG8_BAR; PG8_MMA(1, 0, At, B0); PG8_MMA(1, 1, At, B1); PG8_BAR; PG8_SCHED;
            } else {
            PG8_LDB(B0, 0, 0); PG8_SCHED; PG8_LDA(At, 0, 0); PG8_STAGE(PG8_SA(1, 1), a1 + hstep, voffA);
            PG8_WAIT_L(8); PG8_BAR; PG8_WAIT_L(0); PG8_MMA(0, 0, At, B0); PG8_BAR; PG8_SCHED;
            PG8_LDB(B1, 0, 1); PG8_STAGE(PG8_SB(0, 0), b2, voffB);
            PG8_BAR; PG8_WAIT_L(0); PG8_MMA(0, 1, At, B1); PG8_BAR;
            PG8_LDA(At, 0, 1); PG8_STAGE(PG8_SA(0, 0), a2, voffA);
            PG8_BAR; PG8_WAIT_L(0); PG8_MMA(1, 0, At, B0); PG8_BAR; PG8_SCHED;
            PG8_STAGE(PG8_SB(0, 1), b2 + hstep, voffB);
            PG8_WAIT_V(6); PG8_BAR; PG8_MMA(1, 1, At, B1); PG8_BAR;
            PG8_LDB(B0, 1, 0); PG8_SCHED; PG8_LDA(At, 1, 0); PG8_STAGE(PG8_SA(0, 1), a2 + hstep, voffA);
            PG8_WAIT_L(8); PG8_BAR; PG8_WAIT_L(0); PG8_MMA(0, 0, At, B0); PG8_BAR; PG8_SCHED;
            PG8_LDB(B1, 1, 1); PG8_STAGE(PG8_SB(1, 0), b3, voffB);
            PG8_BAR; PG8_WAIT_L(0); PG8_MMA(0, 1, At, B1); PG8_BAR;
            PG8_LDA(At, 1, 1); PG8_STAGE(PG8_SA(1, 0), a3, voffA);
            PG8_BAR; PG8_WAIT_L(0); PG8_MMA(1, 0, At, B0); PG8_BAR; PG8_SCHED;
            PG8_STAGE(PG8_SB(1, 1), b3 + hstep, voffB);
            PG8_WAIT_V(6); PG8_BAR; PG8_MMA(1, 1, At, B1); PG8_BAR;
            }
        }
        if constexpr (ALIGN_EPI) { if (wr == 0) PG8_BAR; }
        if constexpr (!Epi::AFTER_DRAIN) { E(acc, cur, wr, wc, fr, fq); S.done(cur); }
        if (!has_next) break;
#pragma unroll
        for (int a = 0; a < 2; ++a)
#pragma unroll
            for (int b = 0; b < 2; ++b)
#pragma unroll
                for (int m = 0; m < 4; ++m)
#pragma unroll
                    for (int n = 0; n < 2; ++n) acc[a][b][m][n] = (f32x4){0.f, 0.f, 0.f, 0.f};
        cur = nxt; cA = nA; cB = nB; ++ui;
        if constexpr (ALIGN_EPI) { if (wr == 1) PG8_BAR; }
    }
    PG8_WAIT_V(0);
    if constexpr (!ALIGN_EPI) { if (wr == 0) PG8_BAR; }
    PG8_BAR;
    if constexpr (Epi::AFTER_DRAIN) { E.fused(acc, cur, wr, wc, fr, fq, lds, wid, lane); S.done(cur); }
#undef PG8_SA
#undef PG8_SB
#undef PG8_STAGE
#undef PG8_LDA
#undef PG8_LDB
#undef PG8_MMA
#undef PG8_WAIT_V
#undef PG8_WAIT_L
#undef PG8_BAR
#undef PG8_SCHED
}
}

template <class Epi, bool SS_UNIFORM> struct EpiWrap {
    static constexpr bool PERM = true, AFTER_DRAIN = false;
    Epi e;
    __device__ __forceinline__ void operator()(const pg8::f32x4 (&acc)[2][2][4][2], const pg8::Unit& u, int wr, int wc, int fr, int fq) const {
#pragma unroll
        for (int ai = 0; ai < 2; ++ai)
#pragma unroll
            for (int m = 0; m < 4; ++m) {
                const int row = u.pm * 256 + ai * 128 + wr * 64 + m * 16 + fr;
                float stot = 0.f;
#pragma unroll
                for (int bj = 0; bj < 2; ++bj) {
                    const int c8u = u.pn * 256 + bj * 128 + wc * 32, c8 = c8u + 8 * fq;
                    const float v[8] = {acc[ai][bj][m][0][0], acc[ai][bj][m][0][1], acc[ai][bj][m][0][2], acc[ai][bj][m][0][3], acc[ai][bj][m][1][0], acc[ai][bj][m][1][1], acc[ai][bj][m][1][2], acc[ai][bj][m][1][3]};
                    float s = e.apply(row, c8, v);
                    if (SS_UNIFORM) stot += s;
                    else { float* sp = e.ss_ptr(c8u); if (sp) { s += __shfl_xor(s, 16); s += __shfl_xor(s, 32); if (fq == 0) atomicAdd(sp + row, s); } }
                }
                if (SS_UNIFORM) { float* sp = e.ss_ptr(0); stot += __shfl_xor(stot, 16); stot += __shfl_xor(stot, 32); if (fq == 0) atomicAdd(sp + row, stot); }
                asm volatile("" ::: "memory");
            }
    }
};
template <class Epi, bool SS_UNIFORM>
__device__ __forceinline__ void run_gemm(unsigned char* lds, const bf16_t* A, const bf16_t* Bt, int Mr, int N, int K, const Epi& e) {
    asm volatile("" : "+s"(K));
    pg8::Gemm g{A, Bt, Mr, N, K}; pg8::StaticOrder S; S.init(Mr, N, (int)gridDim.x, (int)blockIdx.x);
    EpiWrap<Epi, SS_UNIFORM> E{e};
    pg8::gemm_phase<EpiWrap<Epi, SS_UNIFORM>, pg8::StaticOrder, true, true>((PG8_LAS unsigned char*)lds, g, S, E);
}

template <class Epi>
__global__ void __launch_bounds__(256) naive_gemm(const bf16_t* __restrict__ A, const bf16_t* __restrict__ Bt, int Mr, int N, int K, Epi E) {
    const long t = (long)blockIdx.x * 256 + threadIdx.x; const int ng = N / 8; const long row = t / ng; const int c8 = (int)(t % ng) * 8;
    if (row >= Mr) return;
    float acc[8] = {0.f, 0.f, 0.f, 0.f, 0.f, 0.f, 0.f, 0.f};
    const bf16_t* a = A + (size_t)row * K; const bf16_t* b = Bt + (size_t)c8 * K;
    for (int k = 0; k < K; k += 8) {
        const u32x4 av = *(const u32x4*)(a + k);
        float af[8] = {__uint_as_float(av.x << 16), __uint_as_float(av.x & 0xffff0000u), __uint_as_float(av.y << 16), __uint_as_float(av.y & 0xffff0000u),
                       __uint_as_float(av.z << 16), __uint_as_float(av.z & 0xffff0000u), __uint_as_float(av.w << 16), __uint_as_float(av.w & 0xffff0000u)};
#pragma unroll
        for (int j = 0; j < 8; ++j) {
            const u32x4 bv = *(const u32x4*)(b + (size_t)j * K + k);
            acc[j] += af[0] * __uint_as_float(bv.x << 16) + af[1] * __uint_as_float(bv.x & 0xffff0000u) + af[2] * __uint_as_float(bv.y << 16) + af[3] * __uint_as_float(bv.y & 0xffff0000u)
                    + af[4] * __uint_as_float(bv.z << 16) + af[5] * __uint_as_float(bv.z & 0xffff0000u) + af[6] * __uint_as_float(bv.w << 16) + af[7] * __uint_as_float(bv.w & 0xffff0000u);
        }
    }
    const float s = E.apply((int)row, c8, acc); float* sp = E.ss_ptr(c8);
    if (sp) atomicAdd(sp + row, s);
}
__device__ __forceinline__ float dot8(const float* q, const bf16_t* k) {
    const u32x4 kv = *(const u32x4*)k;
    return q[0] * __uint_as_float(kv.x << 16) + q[1] * __uint_as_float(kv.x & 0xffff0000u) + q[2] * __uint_as_float(kv.y << 16) + q[3] * __uint_as_float(kv.y & 0xffff0000u)
         + q[4] * __uint_as_float(kv.z << 16) + q[5] * __uint_as_float(kv.z & 0xffff0000u) + q[6] * __uint_as_float(kv.w << 16) + q[7] * __uint_as_float(kv.w & 0xffff0000u);
}
__global__ void __launch_bounds__(64) naive_diff_attn(const bf16_t* __restrict__ Qd, const bf16_t* __restrict__ Kd, const bf16_t* __restrict__ Vd, const int* __restrict__ pos,
                                                      const float* __restrict__ rel_bias, const float* lq1, const float* lk1, const float* lq2, const float* lk2,
                                                      const float* __restrict__ subln, bf16_t* __restrict__ MIX) {
    const int q = blockIdx.x, h = blockIdx.y, b = blockIdx.z, lane = threadIdx.x;
    __shared__ float qs[128];
    const size_t rowq = (size_t)b * SEQ + q;
    qs[lane] = bf2f(Qd[rowq * 512 + h * 128 + lane]); qs[64 + lane] = bf2f(Qd[rowq * 512 + h * 128 + 64 + lane]);
    __syncthreads();
    const float lam = expf(wave_sum(lq1[lane] * lk1[lane])) - expf(wave_sum(lq2[lane] * lk2[lane])) + LAMBDA_INIT;
    const int pq = pos[q];
    float m1 = -1e30f, m2 = -1e30f, l1 = 0.f, l2 = 0.f, o1a = 0.f, o1b = 0.f, o2a = 0.f, o2b = 0.f;
    for (int c = 0; c < SEQ / 64; ++c) {
        const int j = c * 64 + lane; const int dist = pq - pos[j];
        if (__all(dist < 0)) continue;
        const bf16_t* kr = Kd + ((size_t)b * SEQ + j) * 512 + h * 128;
        float s1 = 0.f, s2 = 0.f;
#pragma unroll
        for (int d = 0; d < 64; d += 8) { s1 += dot8(qs + d, kr + d); s2 += dot8(qs + 64 + d, kr + 64 + d); }
        const float bias = rel_bias[t5_bucket(dist) * 4 + h] * LOG2E;
        s1 += bias; s2 += bias;
        if (dist < 0) { s1 = -__builtin_inff(); s2 = -__builtin_inff(); }
        const float mn1 = fmaxf(m1, wave_max(s1)), mn2 = fmaxf(m2, wave_max(s2));
        const float al1 = exp2f(m1 - mn1), al2 = exp2f(m2 - mn2);
        const float p1 = exp2f(s1 - mn1), p2 = exp2f(s2 - mn2);
        l1 = l1 * al1 + wave_sum(p1); l2 = l2 * al2 + wave_sum(p2); m1 = mn1; m2 = mn2;
        o1a *= al1; o1b *= al1; o2a *= al2; o2b *= al2;
        const bf16_t* vr = Vd + ((size_t)b * SEQ + c * 64) * 512 + h * 128 + lane;
        for (int jj = 0; jj < 64; ++jj) {
            const float pj1 = __shfl(p1, jj), pj2 = __shfl(p2, jj);
            const float va = bf2f(vr[(size_t)jj * 512]), vb = bf2f(vr[(size_t)jj * 512 + 64]);
            o1a += pj1 * va; o1b += pj1 * vb; o2a += pj2 * va; o2b += pj2 * vb;
        }
    }
    const float oa = o1a / l1 - lam * (o2a / l2), ob = o1b / l1 - lam * (o2b / l2);
    const float r = rsqrtf(wave_sum(oa * oa + ob * ob) * (1.f / 128.f) + EPS) * (1.f - LAMBDA_INIT);
    bf16_t* o = MIX + rowq * 1024 + h * 128;
    o[lane] = (bf16_t)(cvt_pk_bf16(oa * r * subln[lane], 0.f) & 0xffffu); o[64 + lane] = (bf16_t)(cvt_pk_bf16(ob * r * subln[64 + lane], 0.f) & 0xffffu);
}
__global__ void __launch_bounds__(64) naive_mla_attn(const bf16_t* __restrict__ Qn, const bf16_t* __restrict__ Qp, const bf16_t* __restrict__ Kn, const bf16_t* __restrict__ KPE,
                                                     const bf16_t* __restrict__ Vm, const int* __restrict__ pos, bf16_t* __restrict__ MIX) {
    const int q = blockIdx.x, h = blockIdx.y, b = blockIdx.z, lane = threadIdx.x;
    __shared__ float qs[192];
    const size_t rowq = (size_t)b * SEQ + q;
    qs[lane] = bf2f(Qn[rowq * 512 + h * 128 + lane]); qs[64 + lane] = bf2f(Qn[rowq * 512 + h * 128 + 64 + lane]); qs[128 + lane] = bf2f(Qp[rowq * 256 + h * 64 + lane]);
    __syncthreads();
    const int pq = pos[q];
    float m1 = -1e30f, l1 = 0.f, oa = 0.f, ob = 0.f;
    for (int c = 0; c < SEQ / 64; ++c) {
        const int j = c * 64 + lane; const int dist = pq - pos[j];
        if (__all(dist < 0)) continue;
        const bf16_t* kr = Kn + ((size_t)b * SEQ + j) * 512 + h * 128; const bf16_t* kp = KPE + ((size_t)b * SEQ + j) * 64;
        float s1 = 0.f;
#pragma unroll
        for (int d = 0; d < 128; d += 8) s1 += dot8(qs + d, kr + d);
#pragma unroll
        for (int d = 0; d < 64; d += 8) s1 += dot8(qs + 128 + d, kp + d);
        if (dist < 0) s1 = -__builtin_inff();
        const float mn1 = fmaxf(m1, wave_max(s1)); const float al1 = exp2f(m1 - mn1); const float p1 = exp2f(s1 - mn1);
        l1 = l1 * al1 + wave_sum(p1); m1 = mn1; oa *= al1; ob *= al1;
        const bf16_t* vr = Vm + ((size_t)b * SEQ + c * 64) * 512 + h * 128 + lane;
        for (int jj = 0; jj < 64; ++jj) { const float pj = __shfl(p1, jj); oa += pj * bf2f(vr[(size_t)jj * 512]); ob += pj * bf2f(vr[(size_t)jj * 512 + 64]); }
    }
    bf16_t* o = MIX + rowq * 1024 + 512 + h * 128;
    o[lane] = (bf16_t)(cvt_pk_bf16(oa / l1, 0.f) & 0xffffu); o[64 + lane] = (bf16_t)(cvt_pk_bf16(ob / l1, 0.f) & 0xffffu);
}

namespace att {
#define ALDS __attribute__((address_space(3)))
typedef short bf16x8 __attribute__((ext_vector_type(8)));
typedef short s16x4 __attribute__((ext_vector_type(4)));
typedef float f32x16 __attribute__((ext_vector_type(16)));
typedef ALDS char* lptr;
constexpr int SHM_V = 16384, SHM_KN = 16384, SHM_KP = 8192;
constexpr int OFF_V = 0, OFF_KN = 32768, OFF_KP = 65536, OFF_WS = 81920  , OFF_KPOS = 83968  , OFF_BTAB = 84480  , OFF_END = 84992;
constexpr int OFF_XB = 0;
constexpr float THR = 8.f;

#define KSWZ(row, colB) ((row) * 256 + ((colB) ^ (((row) & 7) << 4)))
#define PSWZ(row, colB) ((row) * 128 + ((colB) ^ ((((row) >> 1) & 7) << 4)))
__device__ __forceinline__ int v_st(int k, int c) { const int kk = (k & ~0xC) | ((k & 4) << 1) | ((k & 8) >> 1); return ((kk >> 3) * 4 + (c >> 5)) * 512 + ((kk & 7) * 32 + (c & 31)) * 2; }
__device__ __forceinline__ int v_rd_base(int lane) { return ((lane & 3) << 3) | (((lane >> 2) & 3) << 6) | (((lane >> 4) & 1) << 5) | (((lane >> 5) & 1) << 8); }
constexpr int v_rd_off(int d0, int ks, int half) { return d0 * 512 + ks * 4096 + half * 2048; }
__device__ __forceinline__ int crow(int r, int hi) { return (r & 3) + 8 * (r >> 2) + 4 * hi; }
__device__ __forceinline__ s16x4 vtr(lptr p) { typedef short v4i16_t __attribute__((ext_vector_type(4))); return __builtin_bit_cast(s16x4, __builtin_amdgcn_ds_read_tr16_b64_v4i16((ALDS v4i16_t*)p)); }

__device__ __forceinline__ void pv_tile(f32x16* o, lptr vb, bf16x8 pa0, bf16x8 pa1, bf16x8 pa2, bf16x8 pa3) {
#pragma unroll
    for (int d0 = 0; d0 < 4; ++d0) {
        s16x4 l0 = vtr(vb + v_rd_off(d0, 0, 0)), h0 = vtr(vb + v_rd_off(d0, 0, 1)), l1 = vtr(vb + v_rd_off(d0, 1, 0)), h1 = vtr(vb + v_rd_off(d0, 1, 1));
        s16x4 l2 = vtr(vb + v_rd_off(d0, 2, 0)), h2 = vtr(vb + v_rd_off(d0, 2, 1)), l3 = vtr(vb + v_rd_off(d0, 3, 0)), h3 = vtr(vb + v_rd_off(d0, 3, 1));
        o[d0] = __builtin_amdgcn_mfma_f32_32x32x16_bf16(pa0, (bf16x8){l0[0], l0[1], l0[2], l0[3], h0[0], h0[1], h0[2], h0[3]}, o[d0], 0, 0, 0);
        o[d0] = __builtin_amdgcn_mfma_f32_32x32x16_bf16(pa1, (bf16x8){l1[0], l1[1], l1[2], l1[3], h1[0], h1[1], h1[2], h1[3]}, o[d0], 0, 0, 0);
        o[d0] = __builtin_amdgcn_mfma_f32_32x32x16_bf16(pa2, (bf16x8){l2[0], l2[1], l2[2], l2[3], h2[0], h2[1], h2[2], h2[3]}, o[d0], 0, 0, 0);
        o[d0] = __builtin_amdgcn_mfma_f32_32x32x16_bf16(pa3, (bf16x8){l3[0], l3[1], l3[2], l3[3], h3[0], h3[1], h3[2], h3[3]}, o[d0], 0, 0, 0);
    }
}
__device__ __forceinline__ float softmax_tile(f32x16& p0, f32x16& p1, float& m_reg, float& l_reg, bf16x8& pa0, bf16x8& pa1, bf16x8& pa2, bf16x8& pa3) {
    float pmax = p0[0];
#pragma unroll
    for (int r = 1; r < 16; ++r) pmax = fmaxf(pmax, p0[r]);
#pragma unroll
    for (int r = 0; r < 16; ++r) pmax = fmaxf(pmax, p1[r]);
    { auto rr = __builtin_amdgcn_permlane32_swap(__float_as_uint(pmax), __float_as_uint(pmax), false, false); pmax = fmaxf(__uint_as_float(rr[0]), __uint_as_float(rr[1])); }
    float alpha = 1.f;
    if (!__builtin_expect(__all(pmax - m_reg <= THR), 1)) { const float mn = fmaxf(m_reg, pmax); alpha = __builtin_amdgcn_exp2f(m_reg - mn); m_reg = mn; }
    const float mm = m_reg;
#pragma unroll
    for (int r = 0; r < 16; ++r) { p0[r] = __builtin_amdgcn_exp2f(p0[r] - mm); p1[r] = __builtin_amdgcn_exp2f(p1[r] - mm); }
    float ps = 0.f;
#pragma unroll
    for (int r = 0; r < 16; ++r) ps += p0[r] + p1[r];
    { auto rr = __builtin_amdgcn_permlane32_swap(__float_as_uint(ps), __float_as_uint(ps), false, false); ps = __uint_as_float(rr[0]) + __uint_as_float(rr[1]); }
    l_reg = l_reg * alpha + ps;
#define PK4(P, B_, OUT) do { unsigned a0 = cvt_pk_bf16(P[B_+0], P[B_+1]), a1 = cvt_pk_bf16(P[B_+2], P[B_+3]), b0 = cvt_pk_bf16(P[B_+4], P[B_+5]), b1 = cvt_pk_bf16(P[B_+6], P[B_+7]); \
        auto r0 = __builtin_amdgcn_permlane32_swap(a0, b0, false, false); auto r1 = __builtin_amdgcn_permlane32_swap(a1, b1, false, false); \
        u32x4 w = {r0[0], r1[0], r0[1], r1[1]}; OUT = __builtin_bit_cast(bf16x8, w); } while (0)
    PK4(p0, 0, pa0); PK4(p0, 8, pa1); PK4(p1, 0, pa2); PK4(p1, 8, pa3);
#undef PK4
    return alpha;
}
__device__ __forceinline__ void rescale_o(f32x16* o, float alpha, ALDS float* al_l, int r32, int hi) {
    if (__any(alpha < 1.f)) {
        if (hi == 0) al_l[r32] = alpha;
#pragma unroll
        for (int r = 0; r < 16; ++r) { const float f = al_l[crow(r, hi)];
#pragma unroll
            for (int d = 0; d < 4; ++d) o[d][r] *= f; }
    }
}

struct MlaT { const bf16_t *Qn, *Qp, *Kn, *KPE, *Vm; const int* pos; bf16_t* MIX; };
__device__ __forceinline__ void mla_unit(const MlaT& T, int b, int h, int qb, lptr lds) {
    int tid_ = threadIdx.x; asm volatile("" : "+v"(tid_));
    const int tid = tid_, wid = __builtin_amdgcn_readfirstlane(tid >> 6), lane = tid & 63, r32 = lane & 31, hi = lane >> 5;
    const size_t rb = (size_t)b * SEQ; const int q0 = qb * 256, qrow = q0 + wid * 32 + r32;
    const int NT = 4 * (qb + 1);
    const int sr = tid >> 4, sc = (tid & 15) * 8, pr = tid >> 3, pc = (tid & 7) * 8;
    const int kws = KSWZ(sr, sc * 2), vst0 = v_st(sr, sc), vst1 = v_st(32 + sr, sc), pws = PSWZ(pr, pc * 2);
    const bf16_t* Kg = T.Kn + (rb + sr) * 512 + h * 128 + sc; const bf16_t* Vg = T.Vm + (rb + sr) * 512 + h * 128 + sc; const bf16_t* Pg = T.KPE + (rb + pr) * 64 + pc;
    const int* posb = T.pos;
    bf16x8 st_k0, st_k1, st_v0, st_v1, st_p; int st_pos = 0;
#define SLOAD(t) do { const size_t ko = (size_t)(t) * 64 * 512; st_k0 = *(const bf16x8*)(Kg + ko); st_k1 = *(const bf16x8*)(Kg + ko + 32 * 512); st_v0 = *(const bf16x8*)(Vg + ko); st_v1 = *(const bf16x8*)(Vg + ko + 32 * 512); \
        st_p = *(const bf16x8*)(Pg + (size_t)(t) * 64 * 64); if (tid < 64) st_pos = posb[(t) * 64 + tid]; } while (0)
#define SWRITE(bf) do { *(ALDS bf16x8*)(lds + OFF_KN + (bf) * SHM_KN + kws) = st_k0; *(ALDS bf16x8*)(lds + OFF_KN + (bf) * SHM_KN + kws + 32 * 256) = st_k1; \
        *(ALDS bf16x8*)(lds + OFF_V + (bf) * SHM_V + vst0) = st_v0; *(ALDS bf16x8*)(lds + OFF_V + (bf) * SHM_V + vst1) = st_v1; \
        *(ALDS bf16x8*)(lds + OFF_KP + (bf) * SHM_KP + pws) = st_p; if (tid < 64) ((ALDS int*)(lds + OFF_KPOS))[(bf) * 64 + tid] = st_pos; } while (0)
    SLOAD(0);
    bf16x8 qr[12];
    { const bf16_t* qn = T.Qn + (rb + qrow) * 512 + h * 128 + hi * 8; const bf16_t* qp = T.Qp + (rb + qrow) * 256 + h * 64 + hi * 8;
#pragma unroll
      for (int d0 = 0; d0 < 8; ++d0) qr[d0] = *(const bf16x8*)(qn + d0 * 16);
#pragma unroll
      for (int d0 = 0; d0 < 4; ++d0) qr[8 + d0] = *(const bf16x8*)(qp + d0 * 16); }
    const int pq = posb[qrow]; const int qpos_lo = __builtin_amdgcn_readfirstlane(posb[q0 + wid * 32]);
    SWRITE(0);
    __syncthreads();
    ALDS float* wsf = (ALDS float*)(lds + OFF_WS) + wid * 64;
    const lptr vb0 = lds + OFF_V + v_rd_base(lane);
    const lptr kb0 = lds + OFF_KN + KSWZ(r32, hi * 16), kb1 = lds + OFF_KN + KSWZ(r32, 32 + hi * 16), kb2 = lds + OFF_KN + KSWZ(r32, 64 + hi * 16), kb3 = lds + OFF_KN + KSWZ(r32, 96 + hi * 16);
    const lptr pb0 = lds + OFF_KP + PSWZ(r32, hi * 16), pb1 = lds + OFF_KP + PSWZ(r32, 32 + hi * 16), pb2 = lds + OFF_KP + PSWZ(r32, 64 + hi * 16), pb3 = lds + OFF_KP + PSWZ(r32, 96 + hi * 16);
    float m_reg = -1e30f, l_reg = 0.f; f32x16 o[4]; o[0] = f32x16{}; o[1] = f32x16{}; o[2] = f32x16{}; o[3] = f32x16{};
#define KSTEP(kb, off, q) do { const bf16x8 a0 = *(const ALDS bf16x8*)((kb) + (off)), a1 = *(const ALDS bf16x8*)((kb) + (off) + 32 * 256); \
        p0 = __builtin_amdgcn_mfma_f32_32x32x16_bf16(a0, q, p0, 0, 0, 0); p1 = __builtin_amdgcn_mfma_f32_32x32x16_bf16(a1, q, p1, 0, 0, 0); } while (0)
#define PSTEP(pb, off, q) do { const bf16x8 a0 = *(const ALDS bf16x8*)((pb) + (off)), a1 = *(const ALDS bf16x8*)((pb) + (off) + 32 * 128); \
        p0 = __builtin_amdgcn_mfma_f32_32x32x16_bf16(a0, q, p0, 0, 0, 0); p1 = __builtin_amdgcn_mfma_f32_32x32x16_bf16(a1, q, p1, 0, 0, 0); } while (0)
#define MLA_STEP(t, BF) do { \
        if ((t) + 1 < NT) SLOAD((t) + 1); \
        f32x16 p0 = f32x16{}, p1 = f32x16{}; \
        KSTEP(kb0, (BF) * SHM_KN, qr[0]); KSTEP(kb1, (BF) * SHM_KN, qr[1]); KSTEP(kb2, (BF) * SHM_KN, qr[2]); KSTEP(kb3, (BF) * SHM_KN, qr[3]); \
        KSTEP(kb0, (BF) * SHM_KN + 128, qr[4]); KSTEP(kb1, (BF) * SHM_KN + 128, qr[5]); KSTEP(kb2, (BF) * SHM_KN + 128, qr[6]); KSTEP(kb3, (BF) * SHM_KN + 128, qr[7]); \
        PSTEP(pb0, (BF) * SHM_KP, qr[8]); PSTEP(pb1, (BF) * SHM_KP, qr[9]); PSTEP(pb2, (BF) * SHM_KP, qr[10]); PSTEP(pb3, (BF) * SHM_KP, qr[11]); \
        const ALDS int* kp_ = (const ALDS int*)(lds + OFF_KPOS) + (BF) * 64; \
        if (qpos_lo < __builtin_amdgcn_readfirstlane(kp_[63])) { \
            _Pragma("unroll") for (int r = 0; r < 16; ++r) { const int c_ = crow(r, hi); if (pq - kp_[c_] < 0) p0[r] = -__builtin_inff(); if (pq - kp_[32 + c_] < 0) p1[r] = -__builtin_inff(); } } \
        bf16x8 pa0, pa1, pa2, pa3; \
        const float alpha = softmax_tile(p0, p1, m_reg, l_reg, pa0, pa1, pa2, pa3); \
        rescale_o(o, alpha, wsf, r32, hi); \
        pv_tile(o, vb0 + (BF) * SHM_V, pa0, pa1, pa2, pa3); \
        if ((t) + 1 < NT) SWRITE((BF) ^ 1); \
        __syncthreads(); } while (0)
    for (int t = 0; t < NT; t += 2) { MLA_STEP(t, 0); MLA_STEP(t + 1, 1); }
#undef MLA_STEP
#undef KSTEP
#undef PSTEP
#undef SLOAD
#undef SWRITE
    if (hi == 0) wsf[32 + r32] = l_reg;
    int hi_e = hi, r32_e = r32; asm volatile("" : "+v"(hi_e), "+v"(r32_e));
    bf16_t* Ow = T.MIX + (rb + q0 + wid * 32 + 4 * hi_e) * 1024 + 512 + h * 128 + r32_e;
#pragma unroll
    for (int r = 0; r < 16; ++r) { const int orow = crow(r, hi); const float rl = __builtin_amdgcn_rcpf(wsf[32 + orow]);
#pragma unroll
        for (int d0 = 0; d0 < 4; ++d0) { const float v = o[d0][r] * rl; const float vn = __shfl_xor(v, 1);
            if ((r32 & 1) == 0) *(unsigned*)(Ow + (size_t)crow(r, 0) * 1024 + d0 * 32) = cvt_pk_bf16(v, vn); } }
    __syncthreads();
}

struct DiffT { const bf16_t *Qd, *Kd, *Vd; const int* pos; const float* rel_bias; const float *lq1, *lk1, *lq2, *lk2; const float* subln; bf16_t* MIX; };
__device__ __forceinline__ void diff_unit(const DiffT& T, int b, int h, int jb, lptr lds) {
    int tid_ = threadIdx.x; asm volatile("" : "+v"(tid_));
    const int tid = tid_, wid = __builtin_amdgcn_readfirstlane(tid >> 6), lane = tid & 63, r32 = lane & 31, hi = lane >> 5;
    const int comp = wid >> 2, wq = wid & 3;
    const size_t rb = (size_t)b * SEQ; const int q0 = jb * 128, qrow = q0 + wq * 32 + r32;
    const int NT = 2 * (jb + 1);
    const int sr = tid >> 4, sc = (tid & 15) * 8;
    const int kws = KSWZ(sr, sc * 2), vst0 = v_st(sr, sc), vst1 = v_st(32 + sr, sc);
    const bf16_t* Kg = T.Kd + (rb + sr) * 512 + h * 128 + sc; const bf16_t* Vg = T.Vd + (rb + sr) * 512 + h * 128 + sc;
    const int* posb = T.pos;
    bf16x8 st_k0, st_k1, st_v0, st_v1; int st_pos = 0;
#define SLOAD(t) do { const size_t ko = (size_t)(t) * 64 * 512; st_k0 = *(const bf16x8*)(Kg + ko); st_k1 = *(const bf16x8*)(Kg + ko + 32 * 512); st_v0 = *(const bf16x8*)(Vg + ko); st_v1 = *(const bf16x8*)(Vg + ko + 32 * 512); \
        if (tid < 64) st_pos = posb[(t) * 64 + tid]; } while (0)
#define SWRITE(bf) do { *(ALDS bf16x8*)(lds + OFF_KN + (bf) * SHM_KN + kws) = st_k0; *(ALDS bf16x8*)(lds + OFF_KN + (bf) * SHM_KN + kws + 32 * 256) = st_k1; \
        *(ALDS bf16x8*)(lds + OFF_V + (bf) * SHM_V + vst0) = st_v0; *(ALDS bf16x8*)(lds + OFF_V + (bf) * SHM_V + vst1) = st_v1; \
        if (tid < 64) ((ALDS int*)(lds + OFF_KPOS))[(bf) * 64 + tid] = st_pos; } while (0)
    SLOAD(0);
    bf16x8 qr[4];
    { const bf16_t* qd = T.Qd + (rb + qrow) * 512 + h * 128 + comp * 64 + hi * 8;
#pragma unroll
      for (int d0 = 0; d0 < 4; ++d0) qr[d0] = *(const bf16x8*)(qd + d0 * 16); }
    const int pq = posb[qrow]; const int qpos_lo = __builtin_amdgcn_readfirstlane(posb[q0 + wq * 32]);
    ALDS float* btab = (ALDS float*)(lds + OFF_BTAB);
    if (tid < 128) btab[tid] = T.rel_bias[t5_bucket(tid) * 4 + h] * LOG2E;
    const float bias31 = T.rel_bias[31 * 4 + h] * LOG2E;
    const float lam = expf(wave_sum(T.lq1[lane] * T.lk1[lane])) - expf(wave_sum(T.lq2[lane] * T.lk2[lane])) + LAMBDA_INIT;
    SWRITE(0);
    __syncthreads();
    ALDS float* wsf = (ALDS float*)(lds + OFF_WS) + wid * 64;
    const lptr vb0 = lds + OFF_V + v_rd_base(lane);
    const lptr kb0 = lds + OFF_KN + comp * 128 + KSWZ(r32, hi * 16), kb1 = lds + OFF_KN + comp * 128 + KSWZ(r32, 32 + hi * 16), kb2 = lds + OFF_KN + comp * 128 + KSWZ(r32, 64 + hi * 16), kb3 = lds + OFF_KN + comp * 128 + KSWZ(r32, 96 + hi * 16);
    float m_reg = -1e30f, l_reg = 0.f; f32x16 o[4]; o[0] = f32x16{}; o[1] = f32x16{}; o[2] = f32x16{}; o[3] = f32x16{};
#define KSTEP(kb, off, q) do { const bf16x8 a0 = *(const ALDS bf16x8*)((kb) + (off)), a1 = *(const ALDS bf16x8*)((kb) + (off) + 32 * 256); \
        p0 = __builtin_amdgcn_mfma_f32_32x32x16_bf16(a0, q, p0, 0, 0, 0); p1 = __builtin_amdgcn_mfma_f32_32x32x16_bf16(a1, q, p1, 0, 0, 0); } while (0)
#define DIFF_STEP(t, BF) do { \
        if ((t) + 1 < NT) SLOAD((t) + 1); \
        const ALDS int* kp_ = (const ALDS int*)(lds + OFF_KPOS) + (BF) * 64; \
        const bool near_ = (qpos_lo - __builtin_amdgcn_readfirstlane(kp_[63])) < 113; \
        f32x16 p0, p1; \
        { const float bi_ = near_ ? 0.f : bias31; _Pragma("unroll") for (int r = 0; r < 16; ++r) { p0[r] = bi_; p1[r] = bi_; } } \
        KSTEP(kb0, (BF) * SHM_KN, qr[0]); KSTEP(kb1, (BF) * SHM_KN, qr[1]); KSTEP(kb2, (BF) * SHM_KN, qr[2]); KSTEP(kb3, (BF) * SHM_KN, qr[3]); \
        if (near_) { \
            _Pragma("unroll") for (int r = 0; r < 16; ++r) { const int c_ = crow(r, hi); const int d0_ = pq - kp_[c_], d1_ = pq - kp_[32 + c_]; \
                p0[r] = d0_ < 0 ? -__builtin_inff() : p0[r] + btab[d0_ < 127 ? d0_ : 127]; p1[r] = d1_ < 0 ? -__builtin_inff() : p1[r] + btab[d1_ < 127 ? d1_ : 127]; } } \
        bf16x8 pa0, pa1, pa2, pa3; \
        const float alpha = softmax_tile(p0, p1, m_reg, l_reg, pa0, pa1, pa2, pa3); \
        rescale_o(o, alpha, wsf, r32, hi); \
        pv_tile(o, vb0 + (BF) * SHM_V, pa0, pa1, pa2, pa3); \
        if ((t) + 1 < NT) SWRITE((BF) ^ 1); \
        __syncthreads(); } while (0)
    for (int t = 0; t < NT; t += 2) { DIFF_STEP(t, 0); DIFF_STEP(t + 1, 1); }
#undef DIFF_STEP
#undef KSTEP
#undef SLOAD
#undef SWRITE
    if (hi == 0) wsf[32 + r32] = l_reg;
    ALDS float* xb = (ALDS float*)(lds + OFF_XB) + wq * 4096 + lane;
    if (comp == 1) {
#pragma unroll
        for (int r = 0; r < 16; ++r) { const float rl = lam * __builtin_amdgcn_rcpf(wsf[32 + crow(r, hi)]);
#pragma unroll
            for (int d0 = 0; d0 < 4; ++d0) xb[(d0 * 16 + r) * 64] = o[d0][r] * rl; }
    }
    __syncthreads();
    if (comp == 0) {
        int hi_e = hi, r32_e = r32; asm volatile("" : "+v"(hi_e), "+v"(r32_e));
        bf16_t* Ow = T.MIX + (rb + q0 + wq * 32 + 4 * hi_e) * 1024 + h * 128 + r32_e;
        float g[4];
#pragma unroll
        for (int d0 = 0; d0 < 4; ++d0) g[d0] = T.subln[d0 * 32 + r32] * (1.f - LAMBDA_INIT);
#pragma unroll
        for (int r = 0; r < 16; ++r) { const int orow = crow(r, hi); const float rl = __builtin_amdgcn_rcpf(wsf[32 + orow]);
            float v[4], s = 0.f;
#pragma unroll
            for (int d0 = 0; d0 < 4; ++d0) { v[d0] = o[d0][r] * rl - xb[(d0 * 16 + r) * 64]; s += v[d0] * v[d0]; }
            s += __shfl_xor(s, 1); s += __shfl_xor(s, 2); s += __shfl_xor(s, 4); s += __shfl_xor(s, 8); s += __shfl_xor(s, 16);
            const float rn = rsqrtf(s * (1.f / 128.f) + EPS);
#pragma unroll
            for (int d0 = 0; d0 < 4; ++d0) { const float y = v[d0] * rn * g[d0]; const float yn = __shfl_xor(y, 1);
                if ((r32 & 1) == 0) *(unsigned*)(Ow + (size_t)crow(r, 0) * 1024 + d0 * 32) = cvt_pk_bf16(y, yn); } }
    }
    __syncthreads();
}

__device__ __forceinline__ void attn_phase(const DiffT& D, const MlaT& Mt, int vcu, int G, unsigned char* lds_) {
    const lptr lds = (lptr)lds_;
    for (int i = vcu; i < 512; i += G) {
        const int x = i >> 5, c = i & 31;
        const int rnd = i / G;
        int bh, s;
        if (G == 256) { const int xc = vcu >> 5, cc = vcu & 31; bh = 4 * xc + 2 * rnd + (cc >> 4); s = cc & 15; } else { bh = i >> 4; s = i & 15; (void)x; (void)c; }
#ifndef NO_DIFF
        diff_unit(D, bh >> 2, bh & 3, 31 - s, lds); diff_unit(D, bh >> 2, bh & 3, s, lds);
#endif
    }
    for (int i = vcu; i < 256; i += G) {
        const int bh = i >> 3, s = i & 7;
#ifndef NO_MLA
        mla_unit(Mt, bh >> 2, bh & 3, 15 - s, lds); mla_unit(Mt, bh >> 2, bh & 3, s, lds);
#endif
    }
}
}

#define LAS __attribute__((address_space(3)))
constexpr int NWAVES = 8, NTHREADS = NWAVES * 64;
constexpr int LDS_BYTES = 147456;
struct Args {
    const float* x; const int* pos; const float* rel_bias; const float* norm_attn; const float* w_in;
    const float *lq1, *lk1, *lq2, *lk2; const float* subln; const float* q_norm; const float* w_uq; const float* kv_norm; const float* w_ukv;
    const float* w_out; const float* norm_mlp; const float* w1; const float* w2; const float* norm_final;
    float* out; unsigned char* ws; int ph_lo, ph_hi;
};
struct Frame { int tid, lane, wave, G, vcu; };

template <class Map>
__device__ __forceinline__ void p0_transpose_item(const float* __restrict__ W, int K, int Nsrc, bf16_t* __restrict__ WT, const float* __restrict__ gain, float* scr, int item, int nblk, int lane, Map map) {
    const int kb = item / nblk, nb = item % nblk, k0 = 64 * kb, n0 = 32 * nb;
    const int src = map(n0 + (lane & 31));
#pragma unroll 8
    for (int i = 0; i < 32; ++i) { const int kk = 2 * i + (lane >> 5); float v = 0.f; if (src >= 0) { v = W[(size_t)(k0 + kk) * Nsrc + src]; if (gain) v *= gain[k0 + kk]; } scr[kk * 33 + (lane & 31)] = v; }
    asm volatile("s_waitcnt lgkmcnt(0)" ::: "memory");
    const int c = lane & 7;
#pragma unroll
    for (int j = 0; j < 4; ++j) { const int n = (lane >> 3) + 8 * j; const float* s = scr + (8 * c) * 33 + n;
        u32x4 o; o.x = cvt_pk_bf16(s[0 * 33], s[1 * 33]); o.y = cvt_pk_bf16(s[2 * 33], s[3 * 33]); o.z = cvt_pk_bf16(s[4 * 33], s[5 * 33]); o.w = cvt_pk_bf16(s[6 * 33], s[7 * 33]);
        *(u32x4*)(WT + (size_t)(n0 + n) * K + k0 + 8 * c) = o; }
    asm volatile("s_waitcnt lgkmcnt(0)" ::: "memory");
}
struct MapId { __device__ int operator()(int n) const { return n; } };
struct MapWin { __device__ int operator()(int n) const { return n < 2176 ? n : (n < 2240 ? 2176 + rope_orig(n - 2176) : -1); } };
struct MapWuq { __device__ int operator()(int n) const { if (n < 512) return (n >> 7) * 192 + (n & 127); const int p = n - 512; return (p >> 6) * 192 + 128 + rope_orig(p & 63); } };
struct MapWukv { __device__ int operator()(int n) const { if (n < 512) return (n >> 7) * 256 + (n & 127); const int p = n - 512; return (p >> 7) * 256 + 128 + (p & 127); } };

__device__ __forceinline__ void p0_prologue(const Args& a, const Frame& F, unsigned char* lds) {
    float* scr = (float*)(lds + F.wave * 16384);
    const int gw = F.vcu * NWAVES + F.wave, NGW = F.G * NWAVES;
    unsigned char* ws = a.ws;
    { f32x4* z = (f32x4*)(ws + WS_SSQ); for (int i = F.vcu * NTHREADS + F.tid; i < 4 * M / 4; i += F.G * NTHREADS) z[i] = (f32x4){0.f, 0.f, 0.f, 0.f}; }
    { f32x2* cs = (f32x2*)(ws + WS_CS);
      for (int i = F.vcu * NTHREADS + F.tid; i < SEQ * 32; i += F.G * NTHREADS) { const int s = i >> 5, f = i & 31;
          const float inv = exp2f(-(float)f * (13.287712379549449f / 32.f)); const float ang = (float)a.pos[s] * inv; float sn, cn; sincos_acc(ang, sn, cn); cs[i] = (f32x2){cn, sn}; } }
    constexpr int I_IN = (DM / 64) * (NINP / 32), I_UQ = (384 / 64) * (768 / 32), I_UKV = (256 / 64) * (1024 / 32), I_OUT = (DM / 64) * (DM / 32), I_1 = (DM / 64) * (FF / 32), I_2 = (FF / 64) * (DM / 32);
    constexpr int NITEMS = I_IN + I_UQ + I_UKV + I_OUT + I_1 + I_2;
    for (int it = gw; it < NITEMS; it += NGW) {
        int r = it;
        if (r < I_IN) { p0_transpose_item(a.w_in, DM, NIN, (bf16_t*)(ws + WS_WIN), nullptr, scr, r, NINP / 32, F.lane, MapWin()); continue; } r -= I_IN;
        if (r < I_UQ) { p0_transpose_item(a.w_uq, 384, 768, (bf16_t*)(ws + WS_WUQ), a.q_norm, scr, r, 768 / 32, F.lane, MapWuq()); continue; } r -= I_UQ;
        if (r < I_UKV) { p0_transpose_item(a.w_ukv, 256, 1024, (bf16_t*)(ws + WS_WUKV), a.kv_norm, scr, r, 1024 / 32, F.lane, MapWukv()); continue; } r -= I_UKV;
        if (r < I_OUT) { p0_transpose_item(a.w_out, DM, DM, (bf16_t*)(ws + WS_WOUT), nullptr, scr, r, DM / 32, F.lane, MapId()); continue; } r -= I_OUT;
        if (r < I_1) { p0_transpose_item(a.w1, DM, FF, (bf16_t*)(ws + WS_W1), a.norm_mlp, scr, r, FF / 32, F.lane, MapId()); continue; } r -= I_1;
        p0_transpose_item(a.w2, FF, DM, (bf16_t*)(ws + WS_W2), nullptr, scr, r, DM / 32, F.lane, MapId());
    }
    { bf16_t* XN = (bf16_t*)(ws + WS_XN);
      f32x4 g[4];
#pragma unroll
      for (int j = 0; j < 4; ++j) g[j] = ((const f32x4*)a.norm_attn)[F.lane + 64 * j];
      for (int m = gw; m < M; m += NGW) {
          const f32x4* xr = (const f32x4*)(a.x + (size_t)m * DM) + F.lane; f32x4 v[4]; float s = 0.f;
#pragma unroll
          for (int j = 0; j < 4; ++j) { v[j] = xr[64 * j]; s += (v[j].x * v[j].x + v[j].y * v[j].y) + (v[j].z * v[j].z + v[j].w * v[j].w); }
          const float rs = rsqrtf(wave_sum(s) * (1.f / DM) + EPS);
          u32x2* o8 = (u32x2*)(XN + (size_t)m * DM) + F.lane;
#pragma unroll
          for (int j = 0; j < 4; ++j) { u32x2 w; w.x = cvt_pk_bf16(v[j].x * rs * g[j].x, v[j].y * rs * g[j].y); w.y = cvt_pk_bf16(v[j].z * rs * g[j].z, v[j].w * rs * g[j].w); o8[64 * j] = w; }
      } }
}
__device__ __forceinline__ void p7_final_norm(const Args& a, const Frame& F) {
    const int gw = F.vcu * NWAVES + F.wave, NGW = F.G * NWAVES;
    const float* ss2 = (const float*)(a.ws + WS_SS2);
    f32x4 g[4];
#pragma unroll
    for (int j = 0; j < 4; ++j) g[j] = ((const f32x4*)a.norm_final)[F.lane + 64 * j];
    for (int m = gw; m < M; m += NGW) {
        f32x4* xr = (f32x4*)(a.out + (size_t)m * DM) + F.lane; const float rs = rsqrtf(ss2[m] * (1.f / DM) + EPS);
#pragma unroll
        for (int j = 0; j < 4; ++j) { f32x4 v = xr[64 * j]; v = v * rs * g[j]; xr[64 * j] = v; }
    }
}

__global__ void __launch_bounds__(NTHREADS, 2) mk_fwd(Args args) {
    extern __shared__ __attribute__((aligned(16))) unsigned char lds[];
    Frame F; F.tid = threadIdx.x; F.lane = F.tid & 63; F.wave = __builtin_amdgcn_readfirstlane(F.tid >> 6); F.G = gridDim.x;
    { const int bx = blockIdx.x; F.vcu = (F.G % 8 == 0) ? (bx % 8) * (F.G / 8) + bx / 8 : bx; }
    const int lo = args.ph_lo, hi = args.ph_hi;
#ifndef PHMASK
#define PHMASK 0xffu
#endif
#define IN(k) (((PHMASK >> (k)) & 1u) && lo <= (k) && (k) < hi)
    unsigned char* ws = args.ws;
    bf16_t *XN = (bf16_t*)(ws + WS_XN), *MIX = (bf16_t*)(ws + WS_MIX), *Qd = (bf16_t*)(ws + WS_QD), *Kd = (bf16_t*)(ws + WS_KD), *Vd = (bf16_t*)(ws + WS_VD), *CQ = (bf16_t*)(ws + WS_CQ), *CKV = (bf16_t*)(ws + WS_CKV),
           *KPE = (bf16_t*)(ws + WS_KPE), *Qn = (bf16_t*)(ws + WS_QN), *Qp = (bf16_t*)(ws + WS_QP), *Kn = (bf16_t*)(ws + WS_KN), *Vm = (bf16_t*)(ws + WS_VM), *X1b = (bf16_t*)(ws + WS_X1B), *H = (bf16_t*)(ws + WS_H);
    float *ssq = (float*)(ws + WS_SSQ), *sskv = (float*)(ws + WS_SSKV), *ss1 = (float*)(ws + WS_SS1), *ss2 = (float*)(ws + WS_SS2);
    const f32x2* cs = (const f32x2*)(ws + WS_CS);
    if (IN(0)) p0_prologue(args, F, lds);
    if (IN(1)) { EpiG1 E{Qd, Kd, Vd, CQ, CKV, KPE, ssq, sskv, cs}; run_gemm<EpiG1, false>(lds, XN, (const bf16_t*)(ws + WS_WIN), M, NINP, DM, E); }
    if (IN(2)) {
#ifndef NO_GQ
                 { EpiQ E{Qn, Qp, ssq, cs}; run_gemm<EpiQ, false>(lds, CQ, (const bf16_t*)(ws + WS_WUQ), M, 768, 384, E); }
#endif
#ifndef NO_GKV
                 { EpiKV E{Kn, Vm, sskv}; run_gemm<EpiKV, false>(lds, CKV, (const bf16_t*)(ws + WS_WUKV), M, 1024, 256, E); }
#endif
    }
    if (IN(3)) { const att::DiffT D{Qd, Kd, Vd, args.pos, args.rel_bias, args.lq1, args.lk1, args.lq2, args.lk2, args.subln, MIX};
                 const att::MlaT Mt{Qn, Qp, Kn, KPE, Vm, args.pos, MIX};
                 att::attn_phase(D, Mt, F.vcu, F.G, lds); }
    if (IN(4)) { EpiOut E{args.x, args.out, X1b, ss1}; run_gemm<EpiOut, true>(lds, MIX, (const bf16_t*)(ws + WS_WOUT), M, DM, DM, E); }
    if (IN(5)) { EpiUp E{H, ss1}; run_gemm<EpiUp, false>(lds, X1b, (const bf16_t*)(ws + WS_W1), M, FF, DM, E); }
    if (IN(6)) { EpiDown E{args.out, ss2}; run_gemm<EpiDown, true>(lds, H, (const bf16_t*)(ws + WS_W2), M, DM, FF, E); }
    if (IN(7)) p7_final_norm(args, F);
#undef IN
}

#ifndef FASTMASK
#define FASTMASK 0x7eu
#endif
extern "C" void kernel_launch(void* const* d_in, const int* in_sizes, int n_in, void* d_out, int out_size, void* d_ws, size_t ws_size, hipStream_t stream) {
    static int grid = 0;
    if (grid == 0) {
        if (n_in != 19 || in_sizes[0] != M * DM || out_size != M * DM || ws_size < WS_END) { fprintf(stderr, "kernel_launch: unexpected shapes (n_in %d, in0 %d, out %d, ws %zu)\n", n_in, n_in > 0 ? in_sizes[0] : -1, out_size, ws_size); grid = -1; return; }
        int dev = 0, cus = 0; (void)hipGetDevice(&dev); if (hipDeviceGetAttribute(&cus, hipDeviceAttributeMultiprocessorCount, dev) != hipSuccess || cus <= 0) cus = 256;
        (void)hipFuncSetAttribute((const void*)mk_fwd, hipFuncAttributeMaxDynamicSharedMemorySize, LDS_BYTES);
        grid = cus;
    }
    if (grid < 0) return;
    Args a{};
    a.x = (const float*)d_in[0]; a.pos = (const int*)d_in[1]; a.rel_bias = (const float*)d_in[2]; a.norm_attn = (const float*)d_in[3]; a.w_in = (const float*)d_in[4];
    a.lq1 = (const float*)d_in[5]; a.lk1 = (const float*)d_in[6]; a.lq2 = (const float*)d_in[7]; a.lk2 = (const float*)d_in[8]; a.subln = (const float*)d_in[9];
    a.q_norm = (const float*)d_in[10]; a.w_uq = (const float*)d_in[11]; a.kv_norm = (const float*)d_in[12]; a.w_ukv = (const float*)d_in[13];
    a.w_out = (const float*)d_in[14]; a.norm_mlp = (const float*)d_in[15]; a.w1 = (const float*)d_in[16]; a.w2 = (const float*)d_in[17]; a.norm_final = (const float*)d_in[18];
    a.out = (float*)d_out; a.ws = (unsigned char*)d_ws;
    unsigned char* ws = (unsigned char*)d_ws;
    bf16_t *XN = (bf16_t*)(ws + WS_XN), *MIX = (bf16_t*)(ws + WS_MIX), *Qd = (bf16_t*)(ws + WS_QD), *Kd = (bf16_t*)(ws + WS_KD), *Vd = (bf16_t*)(ws + WS_VD), *CQ = (bf16_t*)(ws + WS_CQ), *CKV = (bf16_t*)(ws + WS_CKV),
           *KPE = (bf16_t*)(ws + WS_KPE), *Qn = (bf16_t*)(ws + WS_QN), *Qp = (bf16_t*)(ws + WS_QP), *Kn = (bf16_t*)(ws + WS_KN), *Vm = (bf16_t*)(ws + WS_VM), *X1b = (bf16_t*)(ws + WS_X1B), *H = (bf16_t*)(ws + WS_H);
    float *ssq = (float*)(ws + WS_SSQ), *sskv = (float*)(ws + WS_SSKV), *ss1 = (float*)(ws + WS_SS1), *ss2 = (float*)(ws + WS_SS2);
    const f32x2* cs = (const f32x2*)(ws + WS_CS);
    auto launch_phase = [&](int p) { a.ph_lo = p; a.ph_hi = p + 1; hipLaunchKernelGGL(mk_fwd, dim3(grid), dim3(NTHREADS), LDS_BYTES, stream, a); };
    constexpr unsigned FAST = FASTMASK;
    launch_phase(0);
    if (FAST & 2) launch_phase(1);
    else { EpiG1 E{Qd, Kd, Vd, CQ, CKV, KPE, ssq, sskv, cs}; const long nt = (long)M * (NINP / 8); hipLaunchKernelGGL(naive_gemm<EpiG1>, dim3((unsigned)((nt + 255) / 256)), dim3(256), 0, stream, XN, (const bf16_t*)(ws + WS_WIN), M, NINP, DM, E); }
    if (FAST & 4) launch_phase(2);
    else { { EpiQ E{Qn, Qp, ssq, cs}; const long nt = (long)M * (768 / 8); hipLaunchKernelGGL(naive_gemm<EpiQ>, dim3((unsigned)((nt + 255) / 256)), dim3(256), 0, stream, CQ, (const bf16_t*)(ws + WS_WUQ), M, 768, 384, E); }
           { EpiKV E{Kn, Vm, sskv}; const long nt = (long)M * (1024 / 8); hipLaunchKernelGGL(naive_gemm<EpiKV>, dim3((unsigned)((nt + 255) / 256)), dim3(256), 0, stream, CKV, (const bf16_t*)(ws + WS_WUKV), M, 1024, 256, E); } }
    if (FAST & 8) launch_phase(3);
    else { hipLaunchKernelGGL(naive_diff_attn, dim3(SEQ, 4, BATCH), dim3(64), 0, stream, Qd, Kd, Vd, a.pos, a.rel_bias, a.lq1, a.lk1, a.lq2, a.lk2, a.subln, MIX);
           hipLaunchKernelGGL(naive_mla_attn, dim3(SEQ, 4, BATCH), dim3(64), 0, stream, Qn, Qp, Kn, KPE, Vm, a.pos, MIX); }
    if (FAST & 16) launch_phase(4);
    else { EpiOut E{a.x, a.out, X1b, ss1}; const long nt = (long)M * (DM / 8); hipLaunchKernelGGL(naive_gemm<EpiOut>, dim3((unsigned)((nt + 255) / 256)), dim3(256), 0, stream, MIX, (const bf16_t*)(ws + WS_WOUT), M, DM, DM, E); }
    if (FAST & 32) launch_phase(5);
    else { EpiUp E{H, ss1}; const long nt = (long)M * (FF / 8); hipLaunchKernelGGL(naive_gemm<EpiUp>, dim3((unsigned)((nt + 255) / 256)), dim3(256), 0, stream, X1b, (const bf16_t*)(ws + WS_W1), M, FF, DM, E); }
    if (FAST & 64) launch_phase(6);
    else { EpiDown E{a.out, ss2}; const long nt = (long)M * (DM / 8); hipLaunchKernelGGL(naive_gemm<EpiDown>, dim3((unsigned)((nt + 255) / 256)), dim3(256), 0, stream, H, (const bf16_t*)(ws + WS_W2), M, DM, FF, E); }
    launch_phase(7);
}
```
